# Optimizing an MI355X kernel written in HIP

```python
import math
import jax, jax.numpy as jnp
from jax import lax
import numpy as np

D_MODEL = 2048
BATCH = 2
SEQ = 8192
DEPTH = 4

N_MEM = 256
MIX_WIDTH = D_MODEL
ATTN_WIDTH = MIX_WIDTH // 2
HG_WIDTH = MIX_WIDTH - ATTN_WIDTH
ATTN_HEAD_DIM = 128
ATTN_HEADS = ATTN_WIDTH // ATTN_HEAD_DIM
HG_EXPAND = 128
HG_HEADS = HG_WIDTH // HG_EXPAND
HG_VDIM = HG_WIDTH // HG_HEADS
HG_CHUNK = 64
DILATED_BRANCHES = ((128, 1), (512, 4), (2048, 16))
Q_BLOCK = 128
REL_BUCKETS = 32
REL_MAX_DIST = 2048
CROSS_HEADS = 4
CROSS_HEAD_DIM = D_MODEL // CROSS_HEADS
D_FF = ((8 * D_MODEL + 3 * 256 - 1) // (3 * 256)) * 256
IN_SIZES = (ATTN_WIDTH, ATTN_WIDTH, ATTN_WIDTH, HG_WIDTH, HG_WIDTH, HG_WIDTH, HG_WIDTH)
IN_COLS = sum(IN_SIZES)
N_NORMS = 7
RMS_EPS = 1e-6
NEG_INF = -1e30

kernel_name = "hybrid_dilated_attn_hgrn2_trunk"


def rmsnorm(x, g):
    xf = x.astype(jnp.float32)
    y = xf * lax.rsqrt(jnp.mean(xf * xf, axis=-1, keepdims=True) + RMS_EPS)
    return (y * g.astype(jnp.float32)).astype(x.dtype)


def rel_bucket(dist):
    max_exact = REL_BUCKETS // 2
    d_f = jnp.maximum(dist, 1).astype(jnp.float32)
    large = max_exact + (jnp.log(d_f / max_exact) / math.log(REL_MAX_DIST / max_exact)
                         * (REL_BUCKETS - max_exact)).astype(jnp.int32)
    large = jnp.minimum(large, REL_BUCKETS - 1)
    return jnp.where(dist < max_exact, dist, large)


def dilated_branch(q, k, v, rel_bias, window, dilation):
    B, S, H, Dh = q.shape
    band = window // dilation
    assert band <= Q_BLOCK
    M = S // dilation
    Mp = -(-M // Q_BLOCK) * Q_BLOCK
    nb = Mp // Q_BLOCK

    def split(t):
        t = t.reshape(B, M, dilation, H, Dh)
        return jnp.pad(t, ((0, 0), (0, Mp - M), (0, 0), (0, 0), (0, 0)))

    def kwin(t):
        tp = jnp.pad(split(t), ((0, 0), (Q_BLOCK, 0), (0, 0), (0, 0), (0, 0)))
        tp = tp.reshape(B, nb + 1, Q_BLOCK, dilation, H, Dh)
        return jnp.concatenate([tp[:, :-1], tp[:, 1:]], axis=2)

    qs = split(q).reshape(B, nb, Q_BLOCK, dilation, H, Dh)
    ks, vs = kwin(k), kwin(v)
    scores = jnp.einsum('bnqrhd,bnkrhd->bnrhqk', qs, ks).astype(jnp.float32) * (Dh ** -0.5)

    qi = jnp.arange(Q_BLOCK)[:, None]
    kj = jnp.arange(2 * Q_BLOCK)[None, :]
    m = qi - kj + Q_BLOCK
    bucket = rel_bucket(jnp.maximum(m, 0) * dilation)
    bias = jnp.transpose(rel_bias[bucket].astype(jnp.float32), (2, 0, 1))
    band_ok = (m >= 0) & (m <= band)
    blk = jnp.arange(nb)[:, None, None]
    start_ok = (blk * Q_BLOCK + kj[None] - Q_BLOCK) >= 0
    valid = band_ok[None] & start_ok
    logits = jnp.where(valid[None, :, None, None], scores + bias, NEG_INF)
    lse = jax.nn.logsumexp(logits, axis=-1)
    p = jnp.exp(logits - lse[..., None])
    o = jnp.einsum('bnrhqk,bnkrhd->bnqrhd', p.astype(vs.dtype), vs)
    o = o.reshape(B, Mp, dilation, H, Dh)[:, :M].reshape(B, S, H, Dh)
    lse = jnp.transpose(lse, (0, 1, 4, 2, 3)).reshape(B, Mp, dilation, H)[:, :M].reshape(B, S, H)
    return o, lse


def dilated_attention(q, k, v, rel_bias):
    outs, lses = [], []
    for window, dilation in DILATED_BRANCHES:
        o, l = dilated_branch(q, k, v, rel_bias, window, dilation)
        outs.append(o)
        lses.append(l)
    w = jax.nn.softmax(jnp.stack(lses), axis=0)
    o = jnp.einsum('gbsh,gbshd->bshd', w.astype(q.dtype), jnp.stack(outs))
    return o


def hgrn2(fz, iv, qz, gz, lb, hg_gain):
    B, S, _ = fz.shape
    nc = S // HG_CHUNK
    f = lb + (1.0 - lb) * jax.nn.sigmoid(fz.astype(jnp.float32))
    log_f = jnp.log(f)
    kk = 1.0 - f
    qq = jax.nn.silu(qz.astype(jnp.float32))
    vv = iv.astype(jnp.float32)

    def chunks(t, dim):
        return jnp.transpose(t.reshape(B, nc, HG_CHUNK, HG_HEADS, dim), (1, 0, 3, 2, 4))

    xs = (chunks(qq, HG_EXPAND), chunks(kk, HG_EXPAND), chunks(vv, HG_VDIM), chunks(log_f, HG_EXPAND))
    tri = jnp.tril(jnp.ones((HG_CHUNK, HG_CHUNK), dtype=bool))

    def step(state, inp):
        qc, kc, vc, lfc = inp
        b = jnp.cumsum(lfc, axis=-2)
        o_inter = jnp.einsum('bhck,bhkv->bhcv', qc * jnp.exp(b), state)
        diff = b[:, :, :, None, :] - b[:, :, None, :, :]
        decay = jnp.exp(jnp.where(tri[:, :, None], diff, -jnp.inf))
        A = jnp.einsum('bhtk,bhtsk,bhsk->bhts', qc, decay, kc)
        o = o_inter + jnp.einsum('bhts,bhsv->bhtv', A, vc)
        b_last = b[:, :, -1:, :]
        new_state = jnp.exp(b_last[:, :, 0, :])[..., None] * state + \
            jnp.einsum('bhsk,bhsv->bhkv', kc * jnp.exp(b_last - b), vc)
        return new_state, o

    s0 = jnp.zeros((B, HG_HEADS, HG_EXPAND, HG_VDIM), jnp.float32)
    _, o = lax.scan(step, s0, xs)
    o = jnp.transpose(o, (1, 0, 3, 2, 4)).reshape(B, S, HG_HEADS, HG_VDIM)
    o = o * lax.rsqrt(jnp.mean(o * o, axis=-1, keepdims=True) + RMS_EPS)
    o = o * hg_gain.astype(jnp.float32).reshape(HG_HEADS, HG_VDIM)
    o = o.reshape(B, S, HG_WIDTH) * jax.nn.silu(gz.astype(jnp.float32))
    return o.astype(fz.dtype)


def setup_inputs(seed: int = 0) -> dict:
    key = jax.random.key(seed)
    ks = jax.random.split(key, 14)
    f32 = jnp.float32
    nrm = lambda k, shape, scale: jax.random.normal(k, shape, f32) * scale
    return {
        "x": nrm(ks[0], (BATCH, SEQ, D_MODEL), 1.0),
        "mem": nrm(ks[1], (BATCH, N_MEM, D_MODEL), 1.0),
        "rel_bias": nrm(ks[2], (REL_BUCKETS, ATTN_HEADS), 0.5),
        "lb_logits": nrm(ks[3], (DEPTH, HG_WIDTH), 0.5),
        "norm_gains": 1.0 + nrm(ks[4], (DEPTH, N_NORMS, D_MODEL), 0.1),
        "w_in": nrm(ks[5], (DEPTH, D_MODEL, IN_COLS), D_MODEL ** -0.5),
        "hg_norm": 1.0 + nrm(ks[6], (DEPTH, HG_WIDTH), 0.1),
        "w_out": nrm(ks[7], (DEPTH, MIX_WIDTH, D_MODEL), MIX_WIDTH ** -0.5),
        "w_cq": nrm(ks[8], (DEPTH, D_MODEL, D_MODEL), D_MODEL ** -0.5),
        "w_ckv": nrm(ks[9], (DEPTH, D_MODEL, 2 * D_MODEL), D_MODEL ** -0.5),
        "w_co": nrm(ks[10], (DEPTH, D_MODEL, D_MODEL), D_MODEL ** -0.5),
        "w_gate_up": nrm(ks[11], (DEPTH, D_MODEL, 2 * D_FF), D_MODEL ** -0.5),
        "w_down": nrm(ks[12], (DEPTH, D_FF, D_MODEL), D_FF ** -0.5),
    }


def reference(x, mem, rel_bias, lb_logits, norm_gains, w_in, hg_norm, w_out,
              w_cq, w_ckv, w_co, w_gate_up, w_down):
    B, S, D = x.shape
    n_mem = mem.shape[1]
    P = jax.nn.softmax(lb_logits.astype(jnp.float32), axis=0)
    lb_all = jnp.cumsum(P, axis=0) - P
    split_idx = [int(i) for i in np.cumsum(IN_SIZES)[:-1]]

    for l in range(DEPTH):
        g = norm_gains[l]
        h = rmsnorm(x, g[0])
        proj = h @ w_in[l]
        aq, ak, av, fz, iv, qz, gz = jnp.split(proj, split_idx, axis=-1)
        shp = (B, S, ATTN_HEADS, ATTN_HEAD_DIM)
        attn = dilated_attention(aq.reshape(shp), ak.reshape(shp), av.reshape(shp), rel_bias)
        attn = attn.reshape(B, S, ATTN_WIDTH)
        hg = hgrn2(fz, iv, qz, gz, lb_all[l], hg_norm[l])
        mix = jnp.concatenate([attn, hg], axis=-1) @ w_out[l]
        x = x + rmsnorm(mix, g[1])
        hc = rmsnorm(x, g[2])
        mn = rmsnorm(mem, g[3])
        cq = (hc @ w_cq[l]).reshape(B, S, CROSS_HEADS, CROSS_HEAD_DIM)
        ck, cv = jnp.split(mn @ w_ckv[l], 2, axis=-1)
        ck = ck.reshape(B, n_mem, CROSS_HEADS, CROSS_HEAD_DIM)
        cv = cv.reshape(B, n_mem, CROSS_HEADS, CROSS_HEAD_DIM)
        s = jnp.einsum('bshd,bmhd->bhsm', cq, ck).astype(jnp.float32) * (CROSS_HEAD_DIM ** -0.5)
        p = jax.nn.softmax(s, axis=-1).astype(cv.dtype)
        co = jnp.einsum('bhsm,bmhd->bshd', p, cv).reshape(B, S, D) @ w_co[l]
        x = x + rmsnorm(co, g[4])
        hf = rmsnorm(x, g[5])
        gate, up = jnp.split(hf @ w_gate_up[l], 2, axis=-1)
        y = (jax.nn.silu(gate) * up) @ w_down[l]
        x = x + rmsnorm(y, g[6])
    return x
```

```cpp
#include <hip/hip_runtime.h>
#include <cstdio>
#include <cstdint>
namespace pg8 {
#define PG8_LAS __attribute__((address_space(3)))
typedef unsigned short bf16_t;
typedef short bf16x8 __attribute__((ext_vector_type(8)));
typedef float f32x4 __attribute__((ext_vector_type(4)));
typedef unsigned u32x4 __attribute__((ext_vector_type(4)));
constexpr int BM = 256, BK = 64, HALF = 128, HTB = HALF * BK * 2  , STAGE_BYTES = 8 * HTB, NXCD = 8, WGM = 8;

__host__ __device__ __forceinline__ int lds_byte(int r, int c) { const int st = (r >> 4) * 2 + (c >> 5), rr = r & 15, cc = c & 31, ob = rr * 64 + cc * 2; return st * 1024 + (ob ^ (((ob >> 9) & 1) << 5)); }
__host__ __device__ __forceinline__ void stage_rc(int b, int& R, int& C) { const int st = b / 1024, sb = b % 1024, swz = sb ^ (((sb >> 9) & 1) << 5); R = (st >> 1) * 16 + swz / 64; C = (st & 1) * 32 + (swz % 64) / 2; }
__host__ __device__ __forceinline__ int perm32(int rho) { const int n = rho >> 4, i = rho & 15; return 8 * (i >> 2) + 4 * n + (i & 3); }

struct Unit { int pm, pn; };
struct Gemm { const bf16_t* A; const bf16_t* Bt; int M, N, K; };

struct StaticOrder {
    int nM, nN, nwg, G, c;
    __host__ __device__ void init(int M, int N, int G_, int c_) { nM = M / BM; nN = N / BM; nwg = nM * nN; G = G_; c = c_; }
    __host__ __device__ bool next(int i, Unit& u) const {
        const long L = (long)i * G + c; if (L >= nwg) return false;
        int wgid = (int)L; { const int q = nwg / NXCD, r = nwg % NXCD, xcd = wgid % NXCD, off = wgid / NXCD; wgid = (xcd < r ? xcd * (q + 1) : r * (q + 1) + (xcd - r) * q) + off; }
        const int nig = WGM * nN, gid = wgid / nig, fm = gid * WGM, gsz = (nM - fm) < WGM ? (nM - fm) : WGM;
        u.pm = fm + ((wgid % nig) % gsz); u.pn = (wgid % nig) / gsz; return true;
    }
    __device__ __forceinline__ void a_ready(const Unit&) const {}
    __device__ __forceinline__ void done(const Unit&) const {}
};

__device__ __forceinline__ unsigned cvt_pk_bf16(float lo, float hi) { unsigned r; asm volatile("v_cvt_pk_bf16_f32 %0, %1, %2" : "=v"(r) : "v"(lo), "v"(hi)); return r; }
typedef float f32x2 __attribute__((ext_vector_type(2)));
__device__ __forceinline__ f32x2 gelu_pk(f32x2 v) {
    const f32x2 av = __builtin_elementwise_abs(v), d = av * 0.2316418882f + 1.0f;
    f32x2 t; t.x = __builtin_amdgcn_rcpf(d.x); t.y = __builtin_amdgcn_rcpf(d.y);
    f32x2 q = t * 0.5307027145f + (-0.7265760135f); q = q * t + 0.7107068705f; q = q * t + (-0.142248368f); q = q * t + 0.127414796f; q = q * t;
    const f32x2 s = (v * v) * (-0.72134752044f);
    f32x2 e; e.x = __builtin_amdgcn_exp2f(s.x); e.y = __builtin_amdgcn_exp2f(s.y);
    const f32x2 m = v * (q * e), r = v - m;
    f32x2 o; o.x = v.x < 0.f ? m.x : r.x; o.y = v.y < 0.f ? m.y : r.y; return o;
}

__device__ __forceinline__ float silu_f(float g) { return g / (1.0f + __expf(-g)); }
struct EpiScaleBf16 {
    static constexpr bool PERM = true, AFTER_DRAIN = false;
    bf16_t* O; int ldc; const float* rs;
    __device__ __forceinline__ void operator()(const f32x4 (&acc)[2][2][4][2], const Unit& u, int wr, int wc, int fr, int fq) const {
        const int row0 = u.pm * BM + wr * 64 + fr, col0 = u.pn * BM + wc * 32 + 8 * fq;
#pragma unroll
        for (int ai = 0; ai < 2; ++ai)
#pragma unroll
            for (int m = 0; m < 4; ++m) { const int row = row0 + ai * HALF + m * 16; const float s = rs[row]; bf16_t* rowp = O + (size_t)row * ldc + col0;
#pragma unroll
                for (int bj = 0; bj < 2; ++bj) { const f32x4 v0 = acc[ai][bj][m][0] * s, v1 = acc[ai][bj][m][1] * s;
                    u32x4 w; w.x = cvt_pk_bf16(v0[0], v0[1]); w.y = cvt_pk_bf16(v0[2], v0[3]); w.z = cvt_pk_bf16(v1[0], v1[1]); w.w = cvt_pk_bf16(v1[2], v1[3]);
                    *(u32x4*)(rowp + bj * HALF) = w; } }
    }
};
struct EpiF32Stats {
    static constexpr bool PERM = false, AFTER_DRAIN = false;
    float* Y; int ldc; float* part;
    __device__ __forceinline__ void operator()(const f32x4 (&acc)[2][2][4][2], const Unit& u, int wr, int wc, int fr, int fq) const {
        const int row0 = u.pm * BM + wr * 64 + fr, col0 = u.pn * BM + wc * 32 + 4 * fq;
#pragma unroll
        for (int ai = 0; ai < 2; ++ai)
#pragma unroll
            for (int m = 0; m < 4; ++m) { const int row = row0 + ai * HALF + m * 16; float* rowp = Y + (size_t)row * ldc + col0; float s = 0.f;
#pragma unroll
                for (int bj = 0; bj < 2; ++bj)
#pragma unroll
                    for (int n = 0; n < 2; ++n) { const f32x4 v = acc[ai][bj][m][n]; *(f32x4*)(rowp + bj * HALF + n * 16) = v; s += (v[0] * v[0] + v[1] * v[1]) + (v[2] * v[2] + v[3] * v[3]); }
                s += __shfl_xor(s, 16); s += __shfl_xor(s, 32);
                if (fq == 0) part[(size_t)row * 32 + u.pn * 4 + wc] = s; }
    }
};
struct EpiSwiGLU {
    static constexpr bool PERM = true, AFTER_DRAIN = false;
    bf16_t* H; int ldh; const float* rs;
    __device__ __forceinline__ void operator()(const f32x4 (&acc)[2][2][4][2], const Unit& u, int wr, int wc, int fr, int fq) const {
        const int row0 = u.pm * BM + wr * 64 + fr, col0 = u.pn * HALF + wc * 32 + 8 * fq;
#pragma unroll
        for (int ai = 0; ai < 2; ++ai)
#pragma unroll
            for (int m = 0; m < 4; ++m) { const int row = row0 + ai * HALF + m * 16; const float s = rs[row];
                const f32x4 g0 = acc[ai][0][m][0] * s, g1 = acc[ai][0][m][1] * s, u0 = acc[ai][1][m][0] * s, u1 = acc[ai][1][m][1] * s;
                u32x4 w; w.x = cvt_pk_bf16(silu_f(g0[0]) * u0[0], silu_f(g0[1]) * u0[1]); w.y = cvt_pk_bf16(silu_f(g0[2]) * u0[2], silu_f(g0[3]) * u0[3]);
                w.z = cvt_pk_bf16(silu_f(g1[0]) * u1[0], silu_f(g1[1]) * u1[1]); w.w = cvt_pk_bf16(silu_f(g1[2]) * u1[2], silu_f(g1[3]) * u1[3]);
                *(u32x4*)(H + (size_t)row * ldh + col0) = w; }
    }
};

template <class Epi, class Sched, bool ALIGN_EPI = false, bool SP2 = false>
__device__ __forceinline__ void gemm_phase(PG8_LAS unsigned char* lds, const Gemm g, const Sched& S, const Epi& E) {
    int tid_ = threadIdx.x; asm volatile("" : "+v"(tid_));
    const int tid = tid_, wid = __builtin_amdgcn_readfirstlane(tid >> 6), lane = tid & 63, wr = wid >> 2, wc = wid & 3, fr = lane & 15, fq = lane >> 4;
    const int K = g.K, nt = K / BK;
    unsigned voffA[2], voffB[2];
#pragma unroll
    for (int i = 0; i < 2; ++i) { int R, C; stage_rc(tid * 16 + i * 8192, R, C); const int Rb = Epi::PERM ? ((R & ~31) + perm32(R & 31)) : R;
        voffA[i] = (unsigned)(R * K + C) * 2u; voffB[i] = (unsigned)(Rb * K + C) * 2u; }
    const size_t kstep = (size_t)(BK * 2);
    const size_t hstep = (size_t)HALF * K * 2;
    const size_t tstep = 2 * hstep;
    const unsigned ldsw = (unsigned)wid * 1024u;
    const int aoff = lds_byte(wr * 64 + fr, fq * 8), boff = lds_byte(wc * 32 + fr, fq * 8);
#define PG8_SA(b, h) (((b) * 2 + (h)) * HTB)
#define PG8_SB(b, h) ((4 + (b) * 2 + (h)) * HTB)
#define PG8_STAGE(bufoff, gbase, voff) do { _Pragma("unroll") for (int _i = 0; _i < 2; ++_i) \
        __builtin_amdgcn_global_load_lds((const unsigned*)((const char*)(gbase) + (voff)[_i]), (PG8_LAS unsigned*)(lds + (bufoff) + ldsw + _i * 8192), 16, 0, 0); } while (0)
#define PG8_LDA(dst, b, h) do { _Pragma("unroll") for (int m = 0; m < 4; ++m) _Pragma("unroll") for (int k = 0; k < 2; ++k) dst[m][k] = *(const PG8_LAS bf16x8*)(lds + PG8_SA(b, h) + aoff + m * 2048 + k * 1024); } while (0)
#define PG8_LDB(dst, b, h) do { _Pragma("unroll") for (int n = 0; n < 2; ++n) _Pragma("unroll") for (int k = 0; k < 2; ++k) dst[n][k] = *(const PG8_LAS bf16x8*)(lds + PG8_SB(b, h) + boff + n * 2048 + k * 1024); } while (0)
#define PG8_MMA(ai, bj, At, Bt) do { __builtin_amdgcn_s_setprio(1); _Pragma("unroll") for (int m = 0; m < 4; ++m) _Pragma("unroll") for (int n = 0; n < 2; ++n) _Pragma("unroll") for (int k = 0; k < 2; ++k) \
        acc[ai][bj][m][n] = __builtin_amdgcn_mfma_f32_16x16x32_bf16(Bt[n][k], At[m][k], acc[ai][bj][m][n], 0, 0, 0); __builtin_amdgcn_s_setprio(0); } while (0)
#define PG8_WAIT_V(n) asm volatile("s_waitcnt vmcnt(" #n ")" ::: "memory")
#define PG8_WAIT_L(n) asm volatile("s_waitcnt lgkmcnt(" #n ")" ::: "memory")
#define PG8_BAR __builtin_amdgcn_s_barrier()
#define PG8_SCHED __builtin_amdgcn_sched_barrier(0)
    Unit cur, nxt; int ui = 0;
    if (!S.next(0, cur)) return;
    f32x4 acc[2][2][4][2];
#pragma unroll
    for (int a = 0; a < 2; ++a)
#pragma unroll
        for (int b = 0; b < 2; ++b)
#pragma unroll
            for (int m = 0; m < 4; ++m)
#pragma unroll
                for (int n = 0; n < 2; ++n) acc[a][b][m][n] = (f32x4){0.f, 0.f, 0.f, 0.f};
    bf16x8 At[4][2], B0[2][2], B1[2][2];
    const char* cA = (const char*)g.A + (size_t)cur.pm * tstep; const char* cB = (const char*)g.Bt + (size_t)cur.pn * tstep;
    S.a_ready(cur);
    if constexpr (SP2) {
        PG8_STAGE(PG8_SB(0, 0), cB, voffB); PG8_STAGE(PG8_SB(0, 1), cB + hstep, voffB); PG8_STAGE(PG8_SA(0, 0), cA, voffA); PG8_STAGE(PG8_SA(0, 1), cA + hstep, voffA);
        if (wr == 1) PG8_BAR;
        PG8_WAIT_V(2); PG8_BAR;
        PG8_STAGE(PG8_SB(1, 0), cB + kstep, voffB); PG8_STAGE(PG8_SA(1, 0), cA + kstep, voffA); PG8_STAGE(PG8_SB(1, 1), cB + hstep + kstep, voffB);
        PG8_WAIT_V(6); PG8_BAR;
    } else {
        PG8_STAGE(PG8_SB(0, 0), cB, voffB); PG8_STAGE(PG8_SA(0, 0), cA, voffA); PG8_STAGE(PG8_SB(0, 1), cB + hstep, voffB); PG8_STAGE(PG8_SA(0, 1), cA + hstep, voffA);
        if (wr == 1) PG8_BAR;
        PG8_WAIT_V(4); PG8_BAR;
        PG8_STAGE(PG8_SB(1, 0), cB + kstep, voffB); PG8_STAGE(PG8_SA(1, 0), cA + kstep, voffA); PG8_STAGE(PG8_SB(1, 1), cB + hstep + kstep, voffB);
        PG8_WAIT_V(6); PG8_BAR;
    }
    for (;;) {
        const bool has_next = S.next(ui + 1, nxt);
        const char* nA = has_next ? (const char*)g.A + (size_t)nxt.pm * tstep : cA; const char* nB = has_next ? (const char*)g.Bt + (size_t)nxt.pn * tstep : cB;
        for (int t = 0; t < nt; t += 2) {
            const bool last = (t == nt - 2);
            const char* a1 = cA + (size_t)(t + 1) * kstep;
            const char* a2 = last ? nA : cA + (size_t)(t + 2) * kstep; const char* b2 = last ? nB : cB + (size_t)(t + 2) * kstep;
            const char* a3 = a2 + kstep; const char* b3 = b2 + kstep;
            if (last && has_next) S.a_ready(nxt);
            if constexpr (SP2) {
            PG8_LDB(B0, 0, 0); PG8_LDB(B1, 0, 1); PG8_SCHED; PG8_LDA(At, 0, 0); PG8_STAGE(PG8_SA(1, 1), a1 + hstep, voffA);
            PG8_WAIT_V(8); PG8_WAIT_L(0); PG8_BAR; PG8_MMA(0, 0, At, B0); PG8_MMA(0, 1, At, B1); PG8_BAR; PG8_SCHED;
            PG8_LDA(At, 0, 1); PG8_STAGE(PG8_SB(0, 0), b2, voffB); PG8_STAGE(PG8_SB(0, 1), b2 + hstep, voffB); PG8_STAGE(PG8_SA(0, 0), a2, voffA);
            PG8_WAIT_V(8); PG8_WAIT_L(0); PG8_BAR; PG8_MMA(1, 0, At, B0); PG8_MMA(1, 1, At, B1); PG8_BAR; PG8_SCHED;
            PG8_LDB(B0, 1, 0); PG8_LDB(B1, 1, 1); PG8_SCHED; PG8_LDA(At, 1, 0); PG8_STAGE(PG8_SA(0, 1), a2 + hstep, voffA);
            PG8_WAIT_V(8); PG8_WAIT_L(0); PG8_BAR; PG8_MMA(0, 0, At, B0); PG8_MMA(0, 1, At, B1); PG8_BAR; PG8_SCHED;
            PG8_LDA(At, 1, 1); PG8_STAGE(PG8_SB(1, 0), b3, voffB); PG8_STAGE(PG8_SB(1, 1), b3 + hstep, voffB); PG8_STAGE(PG8_SA(1, 0), a3, voffA);
            PG8_WAIT_V(8); PG8_WAIT_L(0); PG8_BAR; PG8_MMA(1, 0, At, B0); PG8_MMA(1, 1, At, B1); PG8_BAR; PG8_SCHED;
            } else {
            PG8_LDB(B0, 0, 0); PG8_SCHED; PG8_LDA(At, 0, 0); PG8_STAGE(PG8_SA(1, 1), a1 + hstep, voffA);
            PG8_WAIT_L(8); PG8_BAR; PG8_WAIT_L(0); PG8_MMA(0, 0, At, B0); PG8_BAR; PG8_SCHED;
            PG8_LDB(B1, 0, 1); PG8_STAGE(PG8_SB(0, 0), b2, voffB);
            PG8_BAR; PG8_WAIT_L(0); PG8_MMA(0, 1, At, B1); PG8_BAR;
            PG8_LDA(At, 0, 1); PG8_STAGE(PG8_SA(0, 0), a2, voffA);
            PG8_BAR; PG8_WAIT_L(0); PG8_MMA(1, 0, At, B0); PG8_BAR; PG8_SCHED;
            PG8_STAGE(PG8_SB(0, 1), b2 + hstep, voffB);
            PG8_WAIT_V(6); PG8_BAR; PG8_MMA(1, 1, At, B1); PG8_BAR;
            PG8_LDB(B0, 1, 0); PG8_SCHED; PG8_LDA(At, 1, 0); PG8_STAGE(PG8_SA(0, 1), a2 + hstep, voffA);
            PG8_WAIT_L(8); PG8_BAR; PG8_WAIT_L(0); PG8_MMA(0, 0, At, B0); PG8_BAR; PG8_SCHED;
            PG8_LDB(B1, 1, 1); PG8_STAGE(PG8_SB(1, 0), b3, voffB);
            PG8_BAR; PG8_WAIT_L(0); PG8_MMA(0, 1, At, B1); PG8_BAR;
            PG8_LDA(At, 1, 1); PG8_STAGE(PG8_SA(1, 0), a3, voffA);
            PG8_BAR; PG8_WAIT_L(0); PG8_MMA(1, 0, At, B0); PG8_BAR; PG8_SCHED;
            PG8_STAGE(PG8_SB(1, 1), b3 + hstep, voffB);
            PG8_WAIT_V(6); PG8_BAR; PG8_MMA(1, 1, At, B1); PG8_BAR;
            }
        }
        if constexpr (ALIGN_EPI) { if (wr == 0) PG8_BAR; }
        if constexpr (!Epi::AFTER_DRAIN) { E(acc, cur, wr, wc, fr, fq); S.done(cur); }
        if (!has_next) break;
#pragma unroll
        for (int a = 0; a < 2; ++a)
#pragma unroll
            for (int b = 0; b < 2; ++b)
#pragma unroll
                for (int m = 0; m < 4; ++m)
#pragma unroll
                    for (int n = 0; n < 2; ++n) acc[a][b][m][n] = (f32x4){0.f, 0.f, 0.f, 0.f};
        cur = nxt; cA = nA; cB = nB; ++ui;
        if constexpr (ALIGN_EPI) { if (wr == 1) PG8_BAR; }
    }
    PG8_WAIT_V(0);
    if constexpr (!ALIGN_EPI) { if (wr == 0) PG8_BAR; }
    PG8_BAR;
    if constexpr (Epi::AFTER_DRAIN) { E.fused(acc, cur, wr, wc, fr, fq, lds, wid, lane); S.done(cur); }
#undef PG8_SA
#undef PG8_SB
#undef PG8_STAGE
#undef PG8_LDA
#undef PG8_LDB
#undef PG8_MMA
#undef PG8_WAIT_V
#undef PG8_WAIT_L
#undef PG8_BAR
#undef PG8_SCHED
}
}
#ifndef PG8_SP2
#define PG8_SP2 true
#endif
#ifndef PG8_ALIGN
#define PG8_ALIGN true
#endif

constexpr int D = 2048, SEQ = 8192, M = 16384, DEPTH = 4, NMEM = 256, MROWS = 512;
constexpr int INC = 7168, DFF = 5632, NGU = 11264, NCKV = 4096;
constexpr float RMS_EPS = 1e-6f;

constexpr size_t MiB = 1u << 20;
constexpr size_t WS_CTL = 0, CTL_ZERO_BYTES = 1 * MiB;
constexpr size_t WS_LB = 1 * MiB;
constexpr size_t WS_BIAS = WS_LB + 16384;
constexpr size_t WS_RSTDX = WS_BIAS + 16384;
constexpr size_t WS_RSTDM = WS_RSTDX + 65536;
constexpr size_t WS_PART = 2 * MiB;
constexpr size_t WS_WIN = 4 * MiB;
constexpr size_t WS_WOUT = WS_WIN + (size_t)DEPTH * INC * D * 2;
constexpr size_t WS_WCQ = WS_WOUT + (size_t)DEPTH * D * D * 2;
constexpr size_t WS_WCKV = WS_WCQ + (size_t)DEPTH * D * D * 2;
constexpr size_t WS_WCO = WS_WCKV + (size_t)DEPTH * NCKV * D * 2;
constexpr size_t WS_WGU = WS_WCO + (size_t)DEPTH * D * D * 2;
constexpr size_t WS_WDN = WS_WGU + (size_t)DEPTH * NGU * D * 2;
constexpr size_t WS_XB = WS_WDN + (size_t)DEPTH * D * DFF * 2;
constexpr size_t WS_MEMB = WS_XB + (size_t)M * D * 2;
constexpr size_t WS_CKV = WS_MEMB + (size_t)MROWS * D * 2;
constexpr size_t WS_PROJ = WS_CKV + (size_t)MROWS * DEPTH * NCKV * 2;
constexpr size_t WS_Y = WS_PROJ + (size_t)M * INC * 2;
constexpr size_t WS_MIX = WS_Y + (size_t)M * D * 4;
constexpr size_t WS_HG = WS_MIX + (size_t)M * D * 2;
constexpr size_t WS_END = WS_HG + (size_t)128 * MiB;
constexpr int CW_BAR = 4096;

constexpr int RING_BYTES = 131072;
constexpr int MISC_OFF = RING_BYTES + 320;
constexpr int LDS_BYTES = 147456;

#define GAS __attribute__((address_space(1)))
#define LAS __attribute__((address_space(3)))
typedef unsigned short bf16;
typedef unsigned v4u __attribute__((ext_vector_type(4)));
typedef unsigned v2u __attribute__((ext_vector_type(2)));
typedef float f32x4 __attribute__((ext_vector_type(4)));
#define LDS_WAIT() asm volatile("s_waitcnt lgkmcnt(0)" ::: "memory")
#define VM_WAIT() asm volatile("s_waitcnt vmcnt(0)" ::: "memory")
__device__ __forceinline__ float bf2f(unsigned b) { return __uint_as_float(b << 16); }
__device__ __forceinline__ unsigned f2bf(float f) { unsigned u = __float_as_uint(f); return (u + 0x7fffu + ((u >> 16) & 1u)) >> 16; }
__device__ __forceinline__ unsigned pk2(float lo, float hi) { return f2bf(lo) | (f2bf(hi) << 16); }
__device__ __forceinline__ float wave_sum(float v) {
#pragma unroll
    for (int o = 1; o < 64; o <<= 1) v += __shfl_xor(v, o);
    return v;
}
__device__ __forceinline__ float wave_max(float v) {
#pragma unroll
    for (int o = 1; o < 64; o <<= 1) v = fmaxf(v, __shfl_xor(v, o));
    return v;
}
__device__ __forceinline__ float silu_f(float g) { return g / (1.0f + __expf(-g)); }
__device__ __forceinline__ int opq_tid() { int t = threadIdx.x; asm volatile("" : "+v"(t)); return t; }
__device__ __forceinline__ unsigned char* opq_ptr(unsigned char* q) { asm volatile("" : "+s"(q)); return q; }
__device__ __forceinline__ int opq_s(int v) { asm volatile("" : "+s"(v)); return v; }

#define XB_TMO      128
#define XB_XCNT(j)  (256  + 64 * (j))
#define XB_XSUB(j)  (1280 + 64 * (j))
#define XB_XGEN(j)  (2304 + 64 * (j))
#define XB_TOP      3328
#define XB_TOPGEN   3392
#define XCD_BAR_WORDS 3456
#define XB_SPIN_CAP (1u << 18)

__device__ __forceinline__ unsigned xb_ld(unsigned* p)              { return __hip_atomic_load(p, __ATOMIC_RELAXED, __HIP_MEMORY_SCOPE_AGENT); }
__device__ __forceinline__ unsigned xb_add(unsigned* p, unsigned v) { return __hip_atomic_fetch_add(p, v, __ATOMIC_RELAXED, __HIP_MEMORY_SCOPE_AGENT); }
__device__ __forceinline__ unsigned xb_xcc_id() { return (unsigned)__builtin_amdgcn_s_getreg((3 << 11) | 20) & 0xFu; }
#define XB_SPIN(cond, bar) do { unsigned _sp = 0; while (cond) { __builtin_amdgcn_s_sleep(1); \
    if ((++_sp & 255u) == 0u) { if (xb_ld(&(bar)[XB_TMO])) break; if (_sp > XB_SPIN_CAP) { atomicAdd(&(bar)[XB_TMO], 1u); break; } } } } while (0)

struct XcdBarrier {
    unsigned* bar; unsigned x;
    volatile LAS unsigned* st;
};

__device__ __forceinline__ XcdBarrier xcd_barrier_post(unsigned* bar, volatile LAS unsigned* st) {
    XcdBarrier b; b.bar = bar; b.x = xb_xcc_id(); b.st = st;
    if (threadIdx.x == 0) (void)xb_add(&bar[XB_XCNT(b.x)], 1u);
    return b;
}
__device__ __forceinline__ void xcd_barrier_complete(unsigned* bar, unsigned x, unsigned& nloc, unsigned& nx) {
    const unsigned G = gridDim.x * gridDim.y * gridDim.z;
    unsigned sum, cnt, mine, sp = 0u;
    for (;;) {
        sum = 0u; cnt = 0u; mine = 0u;
#pragma unroll
        for (unsigned j = 0; j < 16; ++j) { const unsigned c = xb_ld(&bar[XB_XCNT(j)]); sum += c; cnt += (c > 0u) ? 1u : 0u; mine = (j == x) ? c : mine; }
        if (sum == G) break;
        __builtin_amdgcn_s_sleep(1);
        if ((++sp & 255u) == 0u) { if (xb_ld(&bar[XB_TMO])) break; if (sp > XB_SPIN_CAP) { atomicAdd(&bar[XB_TMO], 1u); break; } }
    }
    nloc = mine > 0u ? mine : 1u; nx = cnt > 0u ? cnt : 1u;
}

__device__ __forceinline__ void xcd_barrier(const XcdBarrier& b) {
    asm volatile("s_waitcnt vmcnt(0)" ::: "memory");
    __syncthreads();
    if (threadIdx.x == 0) {
        unsigned* bar = b.bar;
        __builtin_amdgcn_s_waitcnt(0);
        unsigned nloc = b.st[0], nx = b.st[1];
        if (nloc == 0u) { xcd_barrier_complete(bar, b.x, nloc, nx); b.st[0] = nloc; b.st[1] = nx; }
        const unsigned old = xb_add(&bar[XB_XSUB(b.x)], 1u);
        const unsigned gen = old / nloc;
        if (old + 1u == (gen + 1u) * nloc) {
            __builtin_amdgcn_fence(__ATOMIC_RELEASE, "agent");
            asm volatile("s_waitcnt vmcnt(0)" ::: "memory");
            const unsigned og = xb_add(&bar[XB_TOP], 1u);
            const unsigned tg = og / nx;
            if (og + 1u == (tg + 1u) * nx) xb_add(&bar[XB_TOPGEN], 1u);
            else XB_SPIN(xb_ld(&bar[XB_TOPGEN]) == tg, bar);
            __builtin_amdgcn_fence(__ATOMIC_ACQUIRE, "agent");
            xb_add(&bar[XB_XGEN(b.x)], 1u);
            asm volatile("s_waitcnt vmcnt(0)" ::: "memory");
        } else {
            XB_SPIN(xb_ld(&bar[XB_XGEN(b.x)]) == gen, bar);
            __builtin_amdgcn_fence(__ATOMIC_ACQUIRE, "agent");
            asm volatile("s_waitcnt vmcnt(0)" ::: "memory");
        }
    }
    __syncthreads();
}

struct Params {
    const float *x, *mem, *rel_bias, *lb_logits, *gains, *w_in, *hg_norm, *w_out, *w_cq, *w_ckv, *w_co, *w_gu, *w_dn;
    float* out; unsigned char* ws; int ph_lo, ph_hi;
};

__device__ __forceinline__ void transpose_item(const float* W, const float* gain, int K, int N, bf16* WT, int k0, int n0, LAS float* scr, int lane) {
#pragma unroll 8
    for (int i = 0; i < 32; ++i) { const int kk = 2 * i + (lane >> 5); const float g = gain ? gain[k0 + kk] : 1.0f; scr[kk * 33 + (lane & 31)] = W[(size_t)(k0 + kk) * N + n0 + (lane & 31)] * g; }
    LDS_WAIT(); asm volatile("" ::: "memory");
    const int c = lane & 7;
#pragma unroll
    for (int j = 0; j < 4; ++j) { const int n = (lane >> 3) + 8 * j; const LAS float* s = scr + (8 * c) * 33 + n;
        v4u o; o.x = pk2(s[0 * 33], s[1 * 33]); o.y = pk2(s[2 * 33], s[3 * 33]); o.z = pk2(s[4 * 33], s[5 * 33]); o.w = pk2(s[6 * 33], s[7 * 33]);
        *(v4u*)(WT + (size_t)n * K + k0 + 8 * c) = o; }
    LDS_WAIT(); asm volatile("" ::: "memory");
}
constexpr int I_IN = (D / 64) * (INC / 32), I_SQ = (D / 64) * (D / 32), I_CKV = (D / 64) * (NCKV / 32), I_GU = (D / 64) * (NGU / 32), I_DN = (DFF / 64) * (D / 32);
constexpr int ITEMS_L = I_IN + 3 * I_SQ + I_CKV + I_GU + I_DN;

__device__ __forceinline__ int rel_bucket(int dist) {
    if (dist < 16) return dist;
    const float df = (float)dist;
    int large = 16 + (int)(logf(df / 16.0f) / 4.852030263919617f * 16.0f);
    return large < 31 ? large : 31;
}

__device__ __forceinline__ void row_prep(const float* src, float* cpy, bf16* dstb, float* rstd, int lane) {
    const f32x4* s4 = (const f32x4*)src + lane; f32x4 v[8]; float ss = 0.f;
#pragma unroll
    for (int j = 0; j < 8; ++j) { v[j] = s4[64 * j]; ss += (v[j][0] * v[j][0] + v[j][1] * v[j][1]) + (v[j][2] * v[j][2] + v[j][3] * v[j][3]); }
    ss = wave_sum(ss);
    if (lane == 0) *rstd = 1.0f / sqrtf(ss * (1.0f / D) + RMS_EPS);
    v2u* d2 = (v2u*)dstb + lane;
#pragma unroll
    for (int j = 0; j < 8; ++j) { if (cpy) ((f32x4*)cpy + lane)[64 * j] = v[j]; v2u w; w.x = pk2(v[j][0], v[j][1]); w.y = pk2(v[j][2], v[j][3]); d2[64 * j] = w; }
}

__device__ __forceinline__ void ph_prologue(const Params& p, LAS unsigned char* lds) {
    const int tid = opq_tid(), lane = tid & 63, wave = tid >> 6;
    const int gw = opq_s(blockIdx.x) * 8 + wave, ngw = opq_s(gridDim.x) * 8;
    LAS float* scr = (LAS float*)(lds + wave * 16384);
    unsigned char* ws = opq_ptr(p.ws);
    for (int it = gw; it < DEPTH * ITEMS_L; it += ngw) {
        const int l = it / ITEMS_L; int r = it % ITEMS_L;
        const float* g = p.gains + (size_t)l * 7 * D;
        const float* W; const float* gain; int K, N, mode = 0; bf16* WT;
        if (r < I_IN) { W = p.w_in + (size_t)l * D * INC; gain = g; K = D; N = INC; WT = (bf16*)(ws + WS_WIN) + (size_t)l * INC * D; }
        else if ((r -= I_IN) < I_SQ) { W = p.w_out + (size_t)l * D * D; gain = nullptr; K = D; N = D; WT = (bf16*)(ws + WS_WOUT) + (size_t)l * D * D; }
        else if ((r -= I_SQ) < I_SQ) { W = p.w_cq + (size_t)l * D * D; gain = g + 2 * D; K = D; N = D; WT = (bf16*)(ws + WS_WCQ) + (size_t)l * D * D; }
        else if ((r -= I_SQ) < I_CKV) { W = p.w_ckv + (size_t)l * D * NCKV; gain = g + 3 * D; K = D; N = NCKV; WT = (bf16*)(ws + WS_WCKV) + (size_t)l * NCKV * D; }
        else if ((r -= I_CKV) < I_SQ) { W = p.w_co + (size_t)l * D * D; gain = nullptr; K = D; N = D; WT = (bf16*)(ws + WS_WCO) + (size_t)l * D * D; }
        else if ((r -= I_SQ) < I_GU) { W = p.w_gu + (size_t)l * D * NGU; gain = g + 5 * D; K = D; N = NGU; mode = 1; WT = (bf16*)(ws + WS_WGU) + (size_t)l * NGU * D; }
        else { r -= I_GU; W = p.w_dn + (size_t)l * DFF * D; gain = nullptr; K = DFF; N = D; WT = (bf16*)(ws + WS_WDN) + (size_t)l * D * DFF; }
        const int nblk = N / 32, kb = r / nblk, nb = r % nblk, k0 = kb * 64, n0 = nb * 32;
        int orow = n0;
        if (mode == 1) orow = (n0 < DFF) ? 256 * (n0 / 128) + (n0 % 128) : 256 * ((n0 - DFF) / 128) + 128 + ((n0 - DFF) % 128);
        transpose_item(W, gain, K, N, WT + (size_t)orow * K, k0, n0, scr, lane);
    }
    const int gt = blockIdx.x * 512 + tid, ngt = gridDim.x * 512;
    float* lb = (float*)(ws + WS_LB); float* bt = (float*)(ws + WS_BIAS);
    for (int c = gt; c < 1024; c += ngt) {
        float e[4]; float mx = -3e38f;
        for (int l = 0; l < 4; ++l) { e[l] = p.lb_logits[l * 1024 + c]; mx = fmaxf(mx, e[l]); }
        float sum = 0.f; for (int l = 0; l < 4; ++l) { e[l] = expf(e[l] - mx); sum += e[l]; }
        float cum = 0.f; for (int l = 0; l < 4; ++l) { lb[l * 1024 + c] = cum; cum += e[l] / sum; }
    }
    for (int i = gt; i < 3 * 132 * 8; i += ngt) {
        const int h = i & 7, j = (i >> 3) % 132, g = (i >> 3) / 132;
        float v = 0.f; if (j <= 128) v = p.rel_bias[rel_bucket(j << (2 * g)) * 8 + h];
        bt[i] = v;
    }
    for (int row = gw; row < M; row += ngw) row_prep(p.x + (size_t)row * D, p.out + (size_t)row * D, (bf16*)(ws + WS_XB) + (size_t)row * D, (float*)(ws + WS_RSTDX) + row, lane);
    for (int row = gw; row < MROWS; row += ngw) row_prep(p.mem + (size_t)row * D, nullptr, (bf16*)(ws + WS_MEMB) + (size_t)row * D, (float*)(ws + WS_RSTDM) + row, lane);
}

__device__ __forceinline__ void ph_resnorm(const Params& p_, const float* gain) {
    struct { unsigned char* ws; float* out; } p; p.ws = opq_ptr(p_.ws); p.out = p_.out;
    const int tid = opq_tid(), lane = tid & 63, wave = tid >> 6;
    const int gw = opq_s(blockIdx.x) * 8 + wave, ngw = opq_s(gridDim.x) * 8;
    const float* Y = (const float*)(p.ws + WS_Y); const float* part = (const float*)(p.ws + WS_PART);
    bf16* xb = (bf16*)(p.ws + WS_XB); float* rstdx = (float*)(p.ws + WS_RSTDX);
    for (int row = gw; row < M; row += ngw) {
        float ss = (lane < 32) ? part[(size_t)row * 32 + lane] : 0.f; ss = wave_sum(ss);
        const float ry = 1.0f / sqrtf(ss * (1.0f / D) + RMS_EPS);
        const f32x4* y4 = (const f32x4*)(Y + (size_t)row * D) + lane; f32x4* x4 = (f32x4*)(p.out + (size_t)row * D) + lane; const f32x4* g4 = (const f32x4*)gain + lane;
        v2u* d2 = (v2u*)(xb + (size_t)row * D) + lane; float s2 = 0.f;
#pragma unroll
        for (int j = 0; j < 8; ++j) { const f32x4 xn = x4[64 * j] + y4[64 * j] * ry * g4[64 * j]; x4[64 * j] = xn;
            s2 += (xn[0] * xn[0] + xn[1] * xn[1]) + (xn[2] * xn[2] + xn[3] * xn[3]); v2u w; w.x = pk2(xn[0], xn[1]); w.y = pk2(xn[2], xn[3]); d2[64 * j] = w; }
        s2 = wave_sum(s2);
        if (lane == 0) rstdx[row] = 1.0f / sqrtf(s2 * (1.0f / D) + RMS_EPS);
    }
}

__device__ __forceinline__ void ph_attn_naive(const Params& p_, LAS unsigned char* lds) {
    struct { unsigned char* ws; } p; p.ws = opq_ptr(p_.ws);
    const int tid = opq_tid(), lane = tid & 63, wave = tid >> 6;
    const int gw = opq_s(blockIdx.x) * 8 + wave, ngw = opq_s(gridDim.x) * 8;
    LAS float* qs = (LAS float*)(lds + wave * 2560); LAS float* Ls = qs + 128;
    const bf16* proj = (const bf16*)(p.ws + WS_PROJ); const float* bt = (const float*)(p.ws + WS_BIAS); bf16* mix = (bf16*)(p.ws + WS_MIX);
    const float scale = 0.08838834764831845f;
    for (int item = gw; item < M * 8; item += ngw) {
        const int row = item >> 3, h = item & 7, b = row >> 13, t = row & 8191;
        { const unsigned qq = *(const unsigned*)(proj + (size_t)row * INC + h * 128 + 2 * lane); qs[2 * lane] = bf2f(qq & 0xffffu); qs[2 * lane + 1] = bf2f(qq >> 16); }
        LDS_WAIT(); asm volatile("" ::: "memory");
        float lg[9]; float mx = -3e38f;
#pragma unroll
        for (int g = 0; g < 3; ++g)
#pragma unroll
            for (int jj = 0; jj < 3; ++jj) {
                const int j = lane + 64 * jj; float v = -3e38f;
                if (j <= 128) { const int tk = t - (j << (2 * g));
                    if (tk >= 0) { const v4u* kp = (const v4u*)(proj + (size_t)(b * SEQ + tk) * INC + 1024 + h * 128); float dot = 0.f;
                        for (int c = 0; c < 16; ++c) { const v4u kv = kp[c]; const LAS float* q = qs + 8 * c;
                            dot += bf2f(kv.x & 0xffffu) * q[0] + bf2f(kv.x >> 16) * q[1] + bf2f(kv.y & 0xffffu) * q[2] + bf2f(kv.y >> 16) * q[3]
                                 + bf2f(kv.z & 0xffffu) * q[4] + bf2f(kv.z >> 16) * q[5] + bf2f(kv.w & 0xffffu) * q[6] + bf2f(kv.w >> 16) * q[7]; }
                        v = dot * scale + bt[(g * 132 + j) * 8 + h]; } }
                lg[g * 3 + jj] = v; mx = fmaxf(mx, v); }
        mx = wave_max(mx);
        float sum = 0.f;
#pragma unroll
        for (int g = 0; g < 3; ++g)
#pragma unroll
            for (int jj = 0; jj < 3; ++jj) { const int j = lane + 64 * jj; const float v = lg[g * 3 + jj]; const float pj = (v > -1e37f) ? __expf(v - mx) : 0.f; sum += pj; if (j <= 128) Ls[g * 132 + j] = pj; }
        sum = wave_sum(sum);
        LDS_WAIT(); asm volatile("" ::: "memory");
        float o0 = 0.f, o1 = 0.f;
        for (int g = 0; g < 3; ++g) { const int jm = (t >> (2 * g)) < 128 ? (t >> (2 * g)) : 128;
            for (int j = 0; j <= jm; ++j) { const float pj = Ls[g * 132 + j];
                const unsigned vv = *(const unsigned*)(proj + (size_t)(b * SEQ + t - (j << (2 * g))) * INC + 2048 + h * 128 + 2 * lane);
                o0 += pj * bf2f(vv & 0xffffu); o1 += pj * bf2f(vv >> 16); } }
        const float inv = 1.0f / sum;
        *(unsigned*)(mix + (size_t)row * D + h * 128 + 2 * lane) = pk2(o0 * inv, o1 * inv);
        LDS_WAIT(); asm volatile("" ::: "memory");
    }
}

__device__ __forceinline__ void ph_hgrn_naive(const Params& p_, int l, LAS unsigned char* lds) {
    struct { unsigned char* ws; } p; p.ws = opq_ptr(p_.ws);
    const int tid = opq_tid(), v = tid >> 2, kq = tid & 3;
    LAS float* Fs = (LAS float*)lds; LAS float* Qs = Fs + 16 * 128; LAS float* Vs = Qs + 16 * 128;
    const bf16* proj = (const bf16*)(p.ws + WS_PROJ); const float* lb = (const float*)(p.ws + WS_LB) + l * 1024; float* hgo = (float*)(p.ws + WS_HG);
    for (int unit = blockIdx.x; unit < 16; unit += gridDim.x) {
        const int b = unit >> 3, h = unit & 7;
        float S[32];
#pragma unroll
        for (int i = 0; i < 32; ++i) S[i] = 0.f;
        for (int t0 = 0; t0 < SEQ; t0 += 16) {
            __syncthreads();
#pragma unroll
            for (int i = 0; i < 4; ++i) { const int e = tid + 512 * i, ts = e >> 7, k = e & 127; const size_t ro = (size_t)(b * SEQ + t0 + ts) * INC + h * 128 + k;
                const float fz = bf2f(proj[ro + 3072]), iv = bf2f(proj[ro + 4096]), qz = bf2f(proj[ro + 5120]);
                const float lbv = lb[h * 128 + k]; Fs[e] = lbv + (1.0f - lbv) / (1.0f + __expf(-fz)); Qs[e] = silu_f(qz); Vs[e] = iv; }
            __syncthreads();
            for (int ts = 0; ts < 16; ++ts) {
                const float ivv = Vs[ts * 128 + v]; float acc = 0.f;
#pragma unroll
                for (int i = 0; i < 32; ++i) { const float f = Fs[ts * 128 + kq * 32 + i]; S[i] = f * S[i] + (1.0f - f) * ivv; acc += Qs[ts * 128 + kq * 32 + i] * S[i]; }
                acc += __shfl_xor(acc, 1); acc += __shfl_xor(acc, 2);
                if (kq == 0) hgo[(size_t)(b * SEQ + t0 + ts) * 1024 + h * 128 + v] = acc;
            }
        }
    }
    __syncthreads();
}
__device__ __forceinline__ void ph_hg_finish(const Params& p_, int l) {
    struct { unsigned char* ws; const float* hg_norm; } p; p.ws = opq_ptr(p_.ws); p.hg_norm = p_.hg_norm;
    const int tid = opq_tid(), lane = tid & 63, wave = tid >> 6;
    const int gw = opq_s(blockIdx.x) * 8 + wave, ngw = opq_s(gridDim.x) * 8;
    const bf16* proj = (const bf16*)(p.ws + WS_PROJ); const float* hgo = (const float*)(p.ws + WS_HG); bf16* mix = (bf16*)(p.ws + WS_MIX);
    const float* hgain = p.hg_norm + l * 1024;
    for (int item = gw; item < M * 8; item += ngw) {
        const int row = item >> 3, h = item & 7;
        const float o0 = hgo[(size_t)row * 1024 + h * 128 + 2 * lane], o1 = hgo[(size_t)row * 1024 + h * 128 + 2 * lane + 1];
        const float ss = wave_sum(o0 * o0 + o1 * o1); const float r = 1.0f / sqrtf(ss * (1.0f / 128.0f) + RMS_EPS);
        const unsigned gz = *(const unsigned*)(proj + (size_t)row * INC + 6144 + h * 128 + 2 * lane);
        const float g0 = hgain[h * 128 + 2 * lane], g1 = hgain[h * 128 + 2 * lane + 1];
        *(unsigned*)(mix + (size_t)row * D + 1024 + h * 128 + 2 * lane) = pk2(o0 * r * g0 * silu_f(bf2f(gz & 0xffffu)), o1 * r * g1 * silu_f(bf2f(gz >> 16)));
    }
}

__device__ __forceinline__ void ph_cross_naive(const Params& p_, int l, LAS unsigned char* lds) {
    struct { unsigned char* ws; } p; p.ws = opq_ptr(p_.ws);
    const int tid = opq_tid(), lane = tid & 63, wave = tid >> 6;
    const int gw = opq_s(blockIdx.x) * 8 + wave, ngw = opq_s(gridDim.x) * 8;
    LAS float* qs = (LAS float*)(lds + wave * 4096); LAS float* Ps = qs + 512;
    const bf16* cq = (const bf16*)(p.ws + WS_PROJ); const bf16* ckv = (const bf16*)(p.ws + WS_CKV) + l * NCKV; bf16* mix = (bf16*)(p.ws + WS_MIX);
    const float scale = 0.04419417382415922f;
    for (int item = gw; item < M * 4; item += ngw) {
        const int row = item >> 2, h = item & 3, b = row >> 13;
        { const v4u qq = *(const v4u*)(cq + (size_t)row * D + h * 512 + 8 * lane); LAS float* q = qs + 8 * lane;
          q[0] = bf2f(qq.x & 0xffffu); q[1] = bf2f(qq.x >> 16); q[2] = bf2f(qq.y & 0xffffu); q[3] = bf2f(qq.y >> 16); q[4] = bf2f(qq.z & 0xffffu); q[5] = bf2f(qq.z >> 16); q[6] = bf2f(qq.w & 0xffffu); q[7] = bf2f(qq.w >> 16); }
        LDS_WAIT(); asm volatile("" ::: "memory");
        float lg[4]; float mx = -3e38f;
#pragma unroll
        for (int i = 0; i < 4; ++i) { const int m = lane + 64 * i; const v4u* kp = (const v4u*)(ckv + (size_t)(b * NMEM + m) * (DEPTH * NCKV) + h * 512); float dot = 0.f;
            for (int c = 0; c < 64; ++c) { const v4u kv = kp[c]; const LAS float* q = qs + 8 * c;
                dot += bf2f(kv.x & 0xffffu) * q[0] + bf2f(kv.x >> 16) * q[1] + bf2f(kv.y & 0xffffu) * q[2] + bf2f(kv.y >> 16) * q[3]
                     + bf2f(kv.z & 0xffffu) * q[4] + bf2f(kv.z >> 16) * q[5] + bf2f(kv.w & 0xffffu) * q[6] + bf2f(kv.w >> 16) * q[7]; }
            lg[i] = dot * scale; mx = fmaxf(mx, lg[i]); }
        mx = wave_max(mx); float sum = 0.f;
#pragma unroll
        for (int i = 0; i < 4; ++i) { const float pj = __expf(lg[i] - mx); sum += pj; Ps[lane + 64 * i] = pj; }
        sum = wave_sum(sum);
        LDS_WAIT(); asm volatile("" ::: "memory");
        float o[8];
#pragma unroll
        for (int i = 0; i < 8; ++i) o[i] = 0.f;
        for (int m = 0; m < NMEM; ++m) { const float pm = Ps[m]; const v4u vv = *(const v4u*)(ckv + (size_t)(b * NMEM + m) * (DEPTH * NCKV) + 2048 + h * 512 + 8 * lane);
            o[0] += pm * bf2f(vv.x & 0xffffu); o[1] += pm * bf2f(vv.x >> 16); o[2] += pm * bf2f(vv.y & 0xffffu); o[3] += pm * bf2f(vv.y >> 16);
            o[4] += pm * bf2f(vv.z & 0xffffu); o[5] += pm * bf2f(vv.z >> 16); o[6] += pm * bf2f(vv.w & 0xffffu); o[7] += pm * bf2f(vv.w >> 16); }
        const float inv = 1.0f / sum; v4u w; w.x = pk2(o[0] * inv, o[1] * inv); w.y = pk2(o[2] * inv, o[3] * inv); w.z = pk2(o[4] * inv, o[5] * inv); w.w = pk2(o[6] * inv, o[7] * inv);
        *(v4u*)(mix + (size_t)row * D + h * 512 + 8 * lane) = w;
        LDS_WAIT(); asm volatile("" ::: "memory");
    }
}

constexpr int PH_PER_LAYER = 13, PH_BASE = 2, N_PHASES = PH_BASE + DEPTH * PH_PER_LAYER;
__global__ void __launch_bounds__(512, 2) k_fwd(Params p) {
    extern __shared__ __attribute__((aligned(16))) unsigned char lds_raw[];
    LAS unsigned char* lds = (LAS unsigned char*)lds_raw;
    const int tid = threadIdx.x;
    for (int u = tid; u < (LDS_BYTES - RING_BYTES) / 4; u += 512) ((LAS unsigned*)(lds + RING_BYTES))[u] = 0u;
    __syncthreads();
    XcdBarrier bar; { unsigned char* ws = p.ws; bar.bar = (unsigned*)(ws + WS_CTL) + CW_BAR; bar.x = 0; bar.st = nullptr;
    if (p.ph_hi - p.ph_lo > 1) bar = xcd_barrier_post((unsigned*)(ws + WS_CTL) + CW_BAR, (volatile LAS unsigned*)(lds + MISC_OFF) + 8); }
#define RUN(k) (p.ph_lo <= (k) && (k) < p.ph_hi)
#define SEAM(k) do { if (RUN(k) && RUN((k) + 1)) xcd_barrier(bar); } while (0)
#define SITE() unsigned char* ws = opq_ptr(p.ws); const int G = opq_s(gridDim.x), c = opq_s(blockIdx.x); const float* rstdx = (const float*)(ws + WS_RSTDX); \
    bf16* xb = (bf16*)(ws + WS_XB); bf16* proj = (bf16*)(ws + WS_PROJ); bf16* mix = (bf16*)(ws + WS_MIX); float* Y = (float*)(ws + WS_Y); float* part = (float*)(ws + WS_PART); \
    (void)rstdx; (void)xb; (void)proj; (void)mix; (void)Y; (void)part; (void)G; (void)c;
    if (RUN(0)) ph_prologue(p, lds);
    SEAM(0);
    if (RUN(1)) { SITE()
        pg8::Gemm g{(const bf16*)(ws + WS_MEMB), (const bf16*)(ws + WS_WCKV), MROWS, DEPTH * NCKV, D}; pg8::StaticOrder S; S.init(MROWS, DEPTH * NCKV, G, c);
        pg8::EpiScaleBf16 E{(bf16*)(ws + WS_CKV), DEPTH * NCKV, (const float*)(ws + WS_RSTDM)};
        pg8::gemm_phase<pg8::EpiScaleBf16, pg8::StaticOrder, PG8_ALIGN, PG8_SP2>(lds, g, S, E);
    }
    SEAM(1);
    for (int l = 0; l < DEPTH; ++l) {
        const int pb = PH_BASE + l * PH_PER_LAYER;
        const float* gl = p.gains + (size_t)l * 7 * D;
        if (RUN(pb + 0)) { SITE()
            pg8::Gemm g{xb, (const bf16*)(ws + WS_WIN) + (size_t)l * INC * D, M, INC, D}; pg8::StaticOrder S; S.init(M, INC, G, c);
            pg8::EpiScaleBf16 E{proj, INC, rstdx};
            pg8::gemm_phase<pg8::EpiScaleBf16, pg8::StaticOrder, PG8_ALIGN, PG8_SP2>(lds, g, S, E);
        }
        SEAM(pb + 0);
        if (RUN(pb + 1)) ph_attn_naive(p, lds);
        SEAM(pb + 1);
        if (RUN(pb + 2)) ph_hgrn_naive(p, l, lds);
        SEAM(pb + 2);
        if (RUN(pb + 3)) ph_hg_finish(p, l);
        SEAM(pb + 3);
        if (RUN(pb + 4)) { SITE()
            pg8::Gemm g{mix, (const bf16*)(ws + WS_WOUT) + (size_t)l * D * D, M, D, D}; pg8::StaticOrder S; S.init(M, D, G, c);
            pg8::EpiF32Stats E{Y, D, part};
            pg8::gemm_phase<pg8::EpiF32Stats, pg8::StaticOrder, PG8_ALIGN, PG8_SP2>(lds, g, S, E);
        }
        SEAM(pb + 4);
        if (RUN(pb + 5)) ph_resnorm(p, gl + 1 * D);
        SEAM(pb + 5);
        if (RUN(pb + 6)) { SITE()
            pg8::Gemm g{xb, (const bf16*)(ws + WS_WCQ) + (size_t)l * D * D, M, D, D}; pg8::StaticOrder S; S.init(M, D, G, c);
            pg8::EpiScaleBf16 E{proj, D, rstdx};
            pg8::gemm_phase<pg8::EpiScaleBf16, pg8::StaticOrder, PG8_ALIGN, PG8_SP2>(lds, g, S, E);
        }
        SEAM(pb + 6);
        if (RUN(pb + 7)) ph_cross_naive(p, l, lds);
        SEAM(pb + 7);
        if (RUN(pb + 8)) { SITE()
            pg8::Gemm g{mix, (const bf16*)(ws + WS_WCO) + (size_t)l * D * D, M, D, D}; pg8::StaticOrder S; S.init(M, D, G, c);
            pg8::EpiF32Stats E{Y, D, part};
            pg8::gemm_phase<pg8::EpiF32Stats, pg8::StaticOrder, PG8_ALIGN, PG8_SP2>(lds, g, S, E);
        }
        SEAM(pb + 8);
        if (RUN(pb + 9)) ph_resnorm(p, gl + 4 * D);
        SEAM(pb + 9);
        if (RUN(pb + 10)) { SITE()
            pg8::Gemm g{xb, (const bf16*)(ws + WS_WGU) + (size_t)l * NGU * D, M, NGU, D}; pg8::StaticOrder S; S.init(M, NGU, G, c);
            pg8::EpiSwiGLU E{proj, DFF, rstdx};
            pg8::gemm_phase<pg8::EpiSwiGLU, pg8::StaticOrder, PG8_ALIGN, PG8_SP2>(lds, g, S, E);
        }
        SEAM(pb + 10);
        if (RUN(pb + 11)) { SITE()
            pg8::Gemm g{proj, (const bf16*)(ws + WS_WDN) + (size_t)l * D * DFF, M, D, DFF}; pg8::StaticOrder S; S.init(M, D, G, c);
            pg8::EpiF32Stats E{Y, D, part};
            pg8::gemm_phase<pg8::EpiF32Stats, pg8::StaticOrder, PG8_ALIGN, PG8_SP2>(lds, g, S, E);
        }
        SEAM(pb + 11);
        if (RUN(pb + 12)) ph_resnorm(p, gl + 6 * D);
        SEAM(pb + 12);
    }
#undef RUN
#undef SEAM
#undef SITE
}

#ifndef MK_ONE_LAUNCH
#define MK_ONE_LAUNCH 1
#endif
extern "C" void kernel_launch(void* const* d_in, const int* in_sizes, int n_in, void* d_out, int out_size, void* d_ws, size_t ws_size, hipStream_t stream) {
    static int grid = 0;
    if (grid == 0) {
        if (n_in != 13 || in_sizes[0] != M * D || out_size != M * D || ws_size < WS_END) { fprintf(stderr, "kernel_launch: unexpected shapes/workspace: n_in %d in0 %d out %d ws %zu (need %zu); nothing launched\n", n_in, n_in > 0 ? in_sizes[0] : -1, out_size, ws_size, (size_t)WS_END); grid = -1; return; }
        int dev = 0, cus = 0, per_cu = 0;
        if (hipGetDevice(&dev) != hipSuccess || hipDeviceGetAttribute(&cus, hipDeviceAttributeMultiprocessorCount, dev) != hipSuccess) { grid = -1; return; }
        if (hipFuncSetAttribute((const void*)k_fwd, hipFuncAttributeMaxDynamicSharedMemorySize, LDS_BYTES) != hipSuccess) { fprintf(stderr, "kernel_launch: hipFuncSetAttribute failed\n"); grid = -1; return; }
        if (hipOccupancyMaxActiveBlocksPerMultiprocessor(&per_cu, (const void*)k_fwd, 512, LDS_BYTES) != hipSuccess || per_cu < 1) fprintf(stderr, "kernel_launch: note: occupancy query says %d\n", per_cu);
        (void)hipGetLastError();
        grid = cus;
    }
    if (grid < 0) return;
    (void)hipMemsetAsync((char*)d_ws + WS_CTL, 0, CTL_ZERO_BYTES, stream);
    Params p{};
    p.x = (const float*)d_in[0]; p.mem = (const float*)d_in[1]; p.rel_bias = (const float*)d_in[2]; p.lb_logits = (const float*)d_in[3]; p.gains = (const float*)d_in[4];
    p.w_in = (const float*)d_in[5]; p.hg_norm = (const float*)d_in[6]; p.w_out = (const float*)d_in[7]; p.w_cq = (const float*)d_in[8]; p.w_ckv = (const float*)d_in[9];
    p.w_co = (const float*)d_in[10]; p.w_gu = (const float*)d_in[11]; p.w_dn = (const float*)d_in[12];
    p.out = (float*)d_out; p.ws = (unsigned char*)d_ws;
#if MK_ONE_LAUNCH
    p.ph_lo = 0; p.ph_hi = N_PHASES;
    hipLaunchKernelGGL(k_fwd, dim3(grid), dim3(512), LDS_BYTES, stream, p);
#else
    for (int ph = 0; ph < N_PHASES; ++ph) { p.ph_lo = ph; p.ph_hi = ph + 1; hipLaunchKernelGGL(k_fwd, dim3(grid), dim3(512), LDS_BYTES, stream, p); }
#endif
}
```

```cpp
#include <hip/hip_runtime.h>
#include <cstdio>
#include <cstdint>
namespace pg8 {
#define PG8_LAS __attribute__((address_space(3)))
typedef unsigned short bf16_t;
typedef short bf16x8 __attribute__((ext_vector_type(8)));
typedef float f32x4 __attribute__((ext_vector_type(4)));
typedef unsigned u32x4 __attribute__((ext_vector_type(4)));
constexpr int BM = 256, BK = 64, HALF = 128, HTB = HALF * BK * 2  , STAGE_BYTES = 8 * HTB, NXCD = 8, WGM = 8;

__host__ __device__ __forceinline__ int lds_byte(int r, int c) { const int st = (r >> 4) * 2 + (c >> 5), rr = r & 15, cc = c & 31, ob = rr * 64 + cc * 2; return st * 1024 + (ob ^ (((ob >> 9) & 1) << 5)); }
__host__ __device__ __forceinline__ void stage_rc(int b, int& R, int& C) { const int st = b / 1024, sb = b % 1024, swz = sb ^ (((sb >> 9) & 1) << 5); R = (st >> 1) * 16 + swz / 64; C = (st & 1) * 32 + (swz % 64) / 2; }
__host__ __device__ __forceinline__ int perm32(int rho) { const int n = rho >> 4, i = rho & 15; return 8 * (i >> 2) + 4 * n + (i & 3); }

struct Unit { int pm, pn; };
struct Gemm { const bf16_t* A; const bf16_t* Bt; int M, N, K; };

struct StaticOrder {
    int nM, nN, nwg, G, c;
    __host__ __device__ void init(int M, int N, int G_, int c_) { nM = M / BM; nN = N / BM; nwg = nM * nN; G = G_; c = c_; }
    __host__ __device__ bool next(int i, Unit& u) const {
        const long L = (long)i * G + c; if (L >= nwg) return false;
        int wgid = (int)L; { const int q = nwg / NXCD, r = nwg % NXCD, xcd = wgid % NXCD, off = wgid / NXCD; wgid = (xcd < r ? xcd * (q + 1) : r * (q + 1) + (xcd - r) * q) + off; }
        const int nig = WGM * nN, gid = wgid / nig, fm = gid * WGM, gsz = (nM - fm) < WGM ? (nM - fm) : WGM;
        u.pm = fm + ((wgid % nig) % gsz); u.pn = (wgid % nig) / gsz; return true;
    }
    __device__ __forceinline__ void a_ready(const Unit&) const {}
    __device__ __forceinline__ void done(const Unit&) const {}
};

__device__ __forceinline__ unsigned cvt_pk_bf16(float lo, float hi) { unsigned r; asm volatile("v_cvt_pk_bf16_f32 %0, %1, %2" : "=v"(r) : "v"(lo), "v"(hi)); return r; }
typedef float f32x2 __attribute__((ext_vector_type(2)));
__device__ __forceinline__ f32x2 gelu_pk(f32x2 v) {
    const f32x2 av = __builtin_elementwise_abs(v), d = av * 0.2316418882f + 1.0f;
    f32x2 t; t.x = __builtin_amdgcn_rcpf(d.x); t.y = __builtin_amdgcn_rcpf(d.y);
    f32x2 q = t * 0.5307027145f + (-0.7265760135f); q = q * t + 0.7107068705f; q = q * t + (-0.142248368f); q = q * t + 0.127414796f; q = q * t;
    const f32x2 s = (v * v) * (-0.72134752044f);
    f32x2 e; e.x = __builtin_amdgcn_exp2f(s.x); e.y = __builtin_amdgcn_exp2f(s.y);
    const f32x2 m = v * (q * e), r = v - m;
    f32x2 o; o.x = v.x < 0.f ? m.x : r.x; o.y = v.y < 0.f ? m.y : r.y; return o;
}

__device__ __forceinline__ float silu_f(float g) { return g / (1.0f + __expf(-g)); }
struct EpiScaleBf16 {
    static constexpr bool PERM = true, AFTER_DRAIN = false;
    bf16_t* O; int ldc; const float* rs;
    __device__ __forceinline__ void operator()(const f32x4 (&acc)[2][2][4][2], const Unit& u, int wr, int wc, int fr, int fq) const {
        const int row0 = u.pm * BM + wr * 64 + fr, col0 = u.pn * BM + wc * 32 + 8 * fq;
#pragma unroll
        for (int ai = 0; ai < 2; ++ai)
#pragma unroll
            for (int m = 0; m < 4; ++m) { const int row = row0 + ai * HALF + m * 16; const float s = rs[row]; bf16_t* rowp = O + (size_t)row * ldc + col0;
#pragma unroll
                for (int bj = 0; bj < 2; ++bj) { const f32x4 v0 = acc[ai][bj][m][0] * s, v1 = acc[ai][bj][m][1] * s;
                    u32x4 w; w.x = cvt_pk_bf16(v0[0], v0[1]); w.y = cvt_pk_bf16(v0[2], v0[3]); w.z = cvt_pk_bf16(v1[0], v1[1]); w.w = cvt_pk_bf16(v1[2], v1[3]);
                    *(u32x4*)(rowp + bj * HALF) = w; } }
    }
};
struct EpiF32Stats {
    static constexpr bool PERM = false, AFTER_DRAIN = false;
    float* Y; int ldc; float* part;
    __device__ __forceinline__ void operator()(const f32x4 (&acc)[2][2][4][2], const Unit& u, int wr, int wc, int fr, int fq) const {
        const int row0 = u.pm * BM + wr * 64 + fr, col0 = u.pn * BM + wc * 32 + 4 * fq;
#pragma unroll
        for (int ai = 0; ai < 2; ++ai)
#pragma unroll
            for (int m = 0; m < 4; ++m) { const int row = row0 + ai * HALF + m * 16; float* rowp = Y + (size_t)row * ldc + col0; float s = 0.f;
#pragma unroll
                for (int bj = 0; bj < 2; ++bj)
#pragma unroll
                    for (int n = 0; n < 2; ++n) { const f32x4 v = acc[ai][bj][m][n]; *(f32x4*)(rowp + bj * HALF + n * 16) = v; s += (v[0] * v[0] + v[1] * v[1]) + (v[2] * v[2] + v[3] * v[3]); }
                s += __shfl_xor(s, 16); s += __shfl_xor(s, 32);
                if (fq == 0) part[(size_t)row * 32 + u.pn * 4 + wc] = s; }
    }
};
struct EpiSwiGLU {
    static constexpr bool PERM = true, AFTER_DRAIN = false;
    bf16_t* H; int ldh; const float* rs;
    __device__ __forceinline__ void operator()(const f32x4 (&acc)[2][2][4][2], const Unit& u, int wr, int wc, int fr, int fq) const {
        const int row0 = u.pm * BM + wr * 64 + fr, col0 = u.pn * HALF + wc * 32 + 8 * fq;
#pragma unroll
        for (int ai = 0; ai < 2; ++ai)
#pragma unroll
            for (int m = 0; m < 4; ++m) { const int row = row0 + ai * HALF + m * 16; const float s = rs[row];
                const f32x4 g0 = acc[ai][0][m][0] * s, g1 = acc[ai][0][m][1] * s, u0 = acc[ai][1][m][0] * s, u1 = acc[ai][1][m][1] * s;
                u32x4 w; w.x = cvt_pk_bf16(silu_f(g0[0]) * u0[0], silu_f(g0[1]) * u0[1]); w.y = cvt_pk_bf16(silu_f(g0[2]) * u0[2], silu_f(g0[3]) * u0[3]);
                w.z = cvt_pk_bf16(silu_f(g1[0]) * u1[0], silu_f(g1[1]) * u1[1]); w.w = cvt_pk_bf16(silu_f(g1[2]) * u1[2], silu_f(g1[3]) * u1[3]);
                *(u32x4*)(H + (size_t)row * ldh + col0) = w; }
    }
};

struct EpiCkv {
    static constexpr bool PERM = true, AFTER_DRAIN = false;
    bf16_t* CK; bf16_t* CVT; const float* rs;
    __device__ __forceinline__ void operator()(const f32x4 (&acc)[2][2][4][2], const Unit& u, int wr, int wc, int fr, int fq) const {
        const int row0 = u.pm * BM + wr * 64 + fr; const int colt = u.pn * BM, l = colt >> 12, cc = colt & 4095;
        if (cc < 2048) {
            const int col0 = colt + wc * 32 + 8 * fq;
#pragma unroll
            for (int ai = 0; ai < 2; ++ai)
#pragma unroll
                for (int m = 0; m < 4; ++m) { const int row = row0 + ai * HALF + m * 16; const float s = rs[row]; bf16_t* rowp = CK + (size_t)row * 16384 + col0;
#pragma unroll
                    for (int bj = 0; bj < 2; ++bj) { const f32x4 v0 = acc[ai][bj][m][0] * s, v1 = acc[ai][bj][m][1] * s;
                        u32x4 w; w.x = cvt_pk_bf16(v0[0], v0[1]); w.y = cvt_pk_bf16(v0[2], v0[3]); w.z = cvt_pk_bf16(v1[0], v1[1]); w.w = cvt_pk_bf16(v1[2], v1[3]);
                        *(u32x4*)(rowp + bj * HALF) = w; } }
        } else {
#pragma unroll
            for (int ai = 0; ai < 2; ++ai)
#pragma unroll
                for (int m = 0; m < 4; ++m) { const int row = row0 + ai * HALF + m * 16; const float s = rs[row]; const int b = row >> 8, key = row & 255, r = key & 31;
                    const int pos = (key & ~31) + 8 * ((r & 15) >> 2) + (r & 3) + ((r >> 4) << 2);
#pragma unroll
                    for (int bj = 0; bj < 2; ++bj) { const int dfull = cc - 2048 + bj * HALF + wc * 32 + 8 * fq, h = dfull >> 9, d = dfull & 511;
                        bf16_t* o = CVT + ((size_t)(((l * 2 + b) * 4 + h) * 512 + d) * 256 + pos);
                        const f32x4 v0 = acc[ai][bj][m][0] * s, v1 = acc[ai][bj][m][1] * s;
                        const unsigned w0 = cvt_pk_bf16(v0[0], v0[1]), w1 = cvt_pk_bf16(v0[2], v0[3]), w2 = cvt_pk_bf16(v1[0], v1[1]), w3 = cvt_pk_bf16(v1[2], v1[3]);
                        o[0 * 256] = (bf16_t)(w0 & 0xffffu); o[1 * 256] = (bf16_t)(w0 >> 16); o[2 * 256] = (bf16_t)(w1 & 0xffffu); o[3 * 256] = (bf16_t)(w1 >> 16);
                        o[4 * 256] = (bf16_t)(w2 & 0xffffu); o[5 * 256] = (bf16_t)(w2 >> 16); o[6 * 256] = (bf16_t)(w3 & 0xffffu); o[7 * 256] = (bf16_t)(w3 >> 16); } }
        }
    }
};

template <class Epi, class Sched, bool ALIGN_EPI = false, bool SP2 = false>
__device__ __forceinline__ void gemm_phase(PG8_LAS unsigned char* lds, const Gemm g, const Sched& S, const Epi& E) {
    int tid_ = threadIdx.x; asm volatile("" : "+v"(tid_));
    const int tid = tid_, wid = __builtin_amdgcn_readfirstlane(tid >> 6), lane = tid & 63, wr = wid >> 2, wc = wid & 3, fr = lane & 15, fq = lane >> 4;
    const int K = g.K, nt = K / BK;
    unsigned voffA[2], voffB[2];
#pragma unroll
    for (int i = 0; i < 2; ++i) { int R, C; stage_rc(tid * 16 + i * 8192, R, C); const int Rb = Epi::PERM ? ((R & ~31) + perm32(R & 31)) : R;
        voffA[i] = (unsigned)(R * K + C) * 2u; voffB[i] = (unsigned)(Rb * K + C) * 2u; }
    const size_t kstep = (size_t)(BK * 2);
    const size_t hstep = (size_t)HALF * K * 2;
    const size_t tstep = 2 * hstep;
    const unsigned ldsw = (unsigned)wid * 1024u;
    const int aoff = lds_byte(wr * 64 + fr, fq * 8), boff = lds_byte(wc * 32 + fr, fq * 8);
#define PG8_SA(b, h) (((b) * 2 + (h)) * HTB)
#define PG8_SB(b, h) ((4 + (b) * 2 + (h)) * HTB)
#define PG8_STAGE(bufoff, gbase, voff) do { _Pragma("unroll") for (int _i = 0; _i < 2; ++_i) \
        __builtin_amdgcn_global_load_lds((const unsigned*)((const char*)(gbase) + (voff)[_i]), (PG8_LAS unsigned*)(lds + (bufoff) + ldsw + _i * 8192), 16, 0, 0); } while (0)
#define PG8_LDA(dst, b, h) do { _Pragma("unroll") for (int m = 0; m < 4; ++m) _Pragma("unroll") for (int k = 0; k < 2; ++k) dst[m][k] = *(const PG8_LAS bf16x8*)(lds + PG8_SA(b, h) + aoff + m * 2048 + k * 1024); } while (0)
#define PG8_LDB(dst, b, h) do { _Pragma("unroll") for (int n = 0; n < 2; ++n) _Pragma("unroll") for (int k = 0; k < 2; ++k) dst[n][k] = *(const PG8_LAS bf16x8*)(lds + PG8_SB(b, h) + boff + n * 2048 + k * 1024); } while (0)
#define PG8_MMA(ai, bj, At, Bt) do { __builtin_amdgcn_s_setprio(1); _Pragma("unroll") for (int m = 0; m < 4; ++m) _Pragma("unroll") for (int n = 0; n < 2; ++n) _Pragma("unroll") for (int k = 0; k < 2; ++k) \
        acc[ai][bj][m][n] = __builtin_amdgcn_mfma_f32_16x16x32_bf16(Bt[n][k], At[m][k], acc[ai][bj][m][n], 0, 0, 0); __builtin_amdgcn_s_setprio(0); } while (0)
#define PG8_WAIT_V(n) asm volatile("s_waitcnt vmcnt(" #n ")" ::: "memory")
#define PG8_WAIT_L(n) asm volatile("s_waitcnt lgkmcnt(" #n ")" ::: "memory")
#define PG8_BAR __builtin_amdgcn_s_barrier()
#define PG8_SCHED __builtin_amdgcn_sched_barrier(0)
    Unit cur, nxt; int ui = 0;
    if (!S.next(0, cur)) return;
    f32x4 acc[2][2][4][2];
#pragma unroll
    for (int a = 0; a < 2; ++a)
#pragma unroll
        for (int b = 0; b < 2; ++b)
#pragma unroll
            for (int m = 0; m < 4; ++m)
#pragma unroll
                for (int n = 0; n < 2; ++n) acc[a][b][m][n] = (f32x4){0.f, 0.f, 0.f, 0.f};
    bf16x8 At[4][2], B0[2][2], B1[2][2];
    const char* cA = (const char*)g.A + (size_t)cur.pm * tstep; const char* cB = (const char*)g.Bt + (size_t)cur.pn * tstep;
    S.a_ready(cur);
    if constexpr (SP2) {
        PG8_STAGE(PG8_SB(0, 0), cB, voffB); PG8_STAGE(PG8_SB(0, 1), cB + hstep, voffB); PG8_STAGE(PG8_SA(0, 0), cA, voffA); PG8_STAGE(PG8_SA(0, 1), cA + hstep, voffA);
        if (wr == 1) PG8_BAR;
        PG8_WAIT_V(2); PG8_BAR;
        PG8_STAGE(PG8_SB(1, 0), cB + kstep, voffB); PG8_STAGE(PG8_SA(1, 0), cA + kstep, voffA); PG8_STAGE(PG8_SB(1, 1), cB + hstep + kstep, voffB);
        PG8_WAIT_V(6); PG8_BAR;
    } else {
        PG8_STAGE(PG8_SB(0, 0), cB, voffB); PG8_STAGE(PG8_SA(0, 0), cA, voffA); PG8_STAGE(PG8_SB(0, 1), cB + hstep, voffB); PG8_STAGE(PG8_SA(0, 1), cA + hstep, voffA);
        if (wr == 1) PG8_BAR;
        PG8_WAIT_V(4); PG8_BAR;
        PG8_STAGE(PG8_SB(1, 0), cB + kstep, voffB); PG8_STAGE(PG8_SA(1, 0), cA + kstep, voffA); PG8_STAGE(PG8_SB(1, 1), cB + hstep + kstep, voffB);
        PG8_WAIT_V(6); PG8_BAR;
    }
    for (;;) {
        const bool has_next = S.next(ui + 1, nxt);
        const char* nA = has_next ? (const char*)g.A + (size_t)nxt.pm * tstep : cA; const char* nB = has_next ? (const char*)g.Bt + (size_t)nxt.pn * tstep : cB;
        for (int t = 0; t < nt; t += 2) {
            const bool last = (t == nt - 2);
            const char* a1 = cA + (size_t)(t + 1) * kstep;
            const char* a2 = last ? nA : cA + (size_t)(t + 2) * kstep; const char* b2 = last ? nB : cB + (size_t)(t + 2) * kstep;
            const char* a3 = a2 + kstep; const char* b3 = b2 + kstep;
            if (last && has_next) S.a_ready(nxt);
            if constexpr (SP2) {
            PG8_LDB(B0, 0, 0); PG8_LDB(B1, 0, 1); PG8_SCHED; PG8_LDA(At, 0, 0); PG8_STAGE(PG8_SA(1, 1), a1 + hstep, voffA);
            PG8_WAIT_V(8); PG8_WAIT_L(0); PG8_BAR; PG8_MMA(0, 0, At, B0); PG8_MMA(0, 1, At, B1); PG8_BAR; PG8_SCHED;
            PG8_LDA(At, 0, 1); PG8_STAGE(PG8_SB(0, 0), b2, voffB); PG8_STAGE(PG8_SB(0, 1), b2 + hstep, voffB); PG8_STAGE(PG8_SA(0, 0), a2, voffA);
            PG8_WAIT_V(8); PG8_WAIT_L(0); PG8_BAR; PG8_MMA(1, 0, At, B0); PG8_MMA(1, 1, At, B1); PG8_BAR; PG8_SCHED;
            PG8_LDB(B0, 1, 0); PG8_LDB(B1, 1, 1); PG8_SCHED; PG8_LDA(At, 1, 0); PG8_STAGE(PG8_SA(0, 1), a2 + hstep, voffA);
            PG8_WAIT_V(8); PG8_WAIT_L(0); PG8_BAR; PG8_MMA(0, 0, At, B0); PG8_MMA(0, 1, At, B1); PG8_BAR; PG8_SCHED;
            PG8_LDA(At, 1, 1); PG8_STAGE(PG8_SB(1, 0), b3, voffB); PG8_STAGE(PG8_SB(1, 1), b3 + hstep, voffB); PG8_STAGE(PG8_SA(1, 0), a3, voffA);
            PG8_WAIT_V(8); PG8_WAIT_L(0); PG8_BAR; PG8_MMA(1, 0, At, B0); PG8_MMA(1, 1, At, B1); PG8_BAR; PG8_SCHED;
            } else {
            PG8_LDB(B0, 0, 0); PG8_SCHED; PG8_LDA(At, 0, 0); PG8_STAGE(PG8_SA(1, 1), a1 + hstep, voffA);
            PG8_WAIT_L(8); PG8_BAR; PG8_WAIT_L(0); PG8_MMA(0, 0, At, B0); PG8_BAR; PG8_SCHED;
            PG8_LDB(B1, 0, 1); PG8_STAGE(PG8_SB(0, 0), b2, voffB);
            PG8_BAR; PG8_WAIT_L(0); PG8_MMA(0, 1, At, B1); PG8_BAR;
            PG8_LDA(At, 0, 1); PG8_STAGE(PG8_SA(0, 0), a2, voffA);
            PG8_BAR; PG8_WAIT_L(0); PG8_MMA(1, 0, At, B0); PG8_BAR; PG8_SCHED;
            PG8_STAGE(PG8_SB(0, 1), b2 + hstep, voffB);
            PG8_WAIT_V(6); PG8_BAR; PG8_MMA(1, 1, At, B1); PG8_BAR;
            PG8_LDB(B0, 1, 0); PG8_SCHED; PG8_LDA(At, 1, 0); PG8_STAGE(PG8_SA(0, 1), a2 + hstep, voffA);
            PG8_WAIT_L(8); PG8_BAR; PG8_WAIT_L(0); PG8_MMA(0, 0, At, B0); PG8_BAR; PG8_SCHED;
            PG8_LDB(B1, 1, 1); PG8_STAGE(PG8_SB(1, 0), b3, voffB);
            PG8_BAR; PG8_WAIT_L(0); PG8_MMA(0, 1, At, B1); PG8_BAR;
            PG8_LDA(At, 1, 1); PG8_STAGE(PG8_SA(1, 0), a3, voffA);
            PG8_BAR; PG8_WAIT_L(0); PG8_MMA(1, 0, At, B0); PG8_BAR; PG8_SCHED;
            PG8_STAGE(PG8_SB(1, 1), b3 + hstep, voffB);
            PG8_WAIT_V(6); PG8_BAR; PG8_MMA(1, 1, At, B1); PG8_BAR;
            }
        }
        if constexpr (ALIGN_EPI) { if (wr == 0) PG8_BAR; }
        if constexpr (!Epi::AFTER_DRAIN) { E(acc, cur, wr, wc, fr, fq); S.done(cur); }
        if (!has_next) break;
#pragma unroll
        for (int a = 0; a < 2; ++a)
#pragma unroll
            for (int b = 0; b < 2; ++b)
#pragma unroll
                for (int m = 0; m < 4; ++m)
#pragma unroll
                    for (int n = 0; n < 2; ++n) acc[a][b][m][n] = (f32x4){0.f, 0.f, 0.f, 0.f};
        cur = nxt; cA = nA; cB = nB; ++ui;
        if constexpr (ALIGN_EPI) { if (wr == 1) PG8_BAR; }
    }
    PG8_WAIT_V(0);
    if constexpr (!ALIGN_EPI) { if (wr == 0) PG8_BAR; }
    PG8_BAR;
    if constexpr (Epi::AFTER_DRAIN) { E.fused(acc, cur, wr, wc, fr, fq, lds, wid, lane); S.done(cur); }
#undef PG8_SA
#undef PG8_SB
#undef PG8_STAGE
#undef PG8_LDA
#undef PG8_LDB
#undef PG8_MMA
#undef PG8_WAIT_V
#undef PG8_WAIT_L
#undef PG8_BAR
#undef PG8_SCHED
}
}
#ifndef PG8_SP2
#define PG8_SP2 true
#endif
#ifndef PG8_ALIGN
#define PG8_ALIGN true
#endif

constexpr int D = 2048, SEQ = 8192, M = 16384, DEPTH = 4, NMEM = 256, MROWS = 512;
constexpr int INC = 7168, DFF = 5632, NGU = 11264, NCKV = 4096;
constexpr float RMS_EPS = 1e-6f;

constexpr size_t MiB = 1u << 20;
constexpr size_t WS_CTL = 0, CTL_ZERO_BYTES = 1 * MiB;
constexpr size_t WS_LB = 1 * MiB;
constexpr size_t WS_BIAS = WS_LB + 16384;
constexpr size_t WS_RSTDX = WS_BIAS + 16384;
constexpr size_t WS_RSTDM = WS_RSTDX + 65536;
constexpr size_t WS_PART = 2 * MiB;
constexpr size_t WS_WIN = 4 * MiB;
constexpr size_t WS_WOUT = WS_WIN + (size_t)DEPTH * INC * D * 2;
constexpr size_t WS_WCQ = WS_WOUT + (size_t)DEPTH * D * D * 2;
constexpr size_t WS_WCKV = WS_WCQ + (size_t)DEPTH * D * D * 2;
constexpr size_t WS_WCO = WS_WCKV + (size_t)DEPTH * NCKV * D * 2;
constexpr size_t WS_WGU = WS_WCO + (size_t)DEPTH * D * D * 2;
constexpr size_t WS_WDN = WS_WGU + (size_t)DEPTH * NGU * D * 2;
constexpr size_t WS_XB = WS_WDN + (size_t)DEPTH * D * DFF * 2;
constexpr size_t WS_MEMB = WS_XB + (size_t)M * D * 2;
constexpr size_t WS_CKV = WS_MEMB + (size_t)MROWS * D * 2;
constexpr size_t WS_CVT = WS_CKV + (size_t)MROWS * DEPTH * NCKV * 2;
constexpr size_t WS_PROJ = WS_CVT + (size_t)DEPTH * 2 * 4 * 512 * 256 * 2;
constexpr size_t WS_Y = WS_PROJ + (size_t)M * INC * 2;
constexpr size_t WS_MIX = WS_Y + (size_t)M * D * 4;
constexpr size_t WS_HG = WS_MIX + (size_t)M * D * 2;
constexpr size_t WS_END = WS_HG + (size_t)128 * MiB;
constexpr int CW_BAR = 4096;

constexpr int RING_BYTES = 131072;
constexpr int MISC_OFF = RING_BYTES + 320;
constexpr int LDS_BYTES = 147456;

#define GAS __attribute__((address_space(1)))
#define LAS __attribute__((address_space(3)))
typedef unsigned short bf16;
typedef unsigned v4u __attribute__((ext_vector_type(4)));
typedef unsigned v2u __attribute__((ext_vector_type(2)));
typedef float f32x4 __attribute__((ext_vector_type(4)));
typedef short bf16x8 __attribute__((ext_vector_type(8)));
#define LDS_WAIT() asm volatile("s_waitcnt lgkmcnt(0)" ::: "memory")
#define VM_WAIT() asm volatile("s_waitcnt vmcnt(0)" ::: "memory")
__device__ __forceinline__ float bf2f(unsigned b) { return __uint_as_float(b << 16); }
__device__ __forceinline__ unsigned f2bf(float f) { unsigned u = __float_as_uint(f); return (u + 0x7fffu + ((u >> 16) & 1u)) >> 16; }
__device__ __forceinline__ unsigned pk2(float lo, float hi) { return f2bf(lo) | (f2bf(hi) << 16); }
__device__ __forceinline__ float wave_sum(float v) {
#pragma unroll
    for (int o = 1; o < 64; o <<= 1) v += __shfl_xor(v, o);
    return v;
}
__device__ __forceinline__ float wave_max(float v) {
#pragma unroll
    for (int o = 1; o < 64; o <<= 1) v = fmaxf(v, __shfl_xor(v, o));
    return v;
}
__device__ __forceinline__ float silu_f(float g) { return g / (1.0f + __expf(-g)); }
__device__ __forceinline__ int opq_tid() { int t = threadIdx.x; asm volatile("" : "+v"(t)); return t; }
__device__ __forceinline__ unsigned char* opq_ptr(unsigned char* q) { asm volatile("" : "+s"(q)); return q; }
__device__ __forceinline__ int opq_s(int v) { asm volatile("" : "+s"(v)); return v; }

#define XB_TMO      128
#define XB_XCNT(j)  (256  + 64 * (j))
#define XB_XSUB(j)  (1280 + 64 * (j))
#define XB_XGEN(j)  (2304 + 64 * (j))
#define XB_TOP      3328
#define XB_TOPGEN   3392
#define XCD_BAR_WORDS 3456
#define XB_SPIN_CAP (1u << 18)

__device__ __forceinline__ unsigned xb_ld(unsigned* p)              { return __hip_atomic_load(p, __ATOMIC_RELAXED, __HIP_MEMORY_SCOPE_AGENT); }
__device__ __forceinline__ unsigned xb_add(unsigned* p, unsigned v) { return __hip_atomic_fetch_add(p, v, __ATOMIC_RELAXED, __HIP_MEMORY_SCOPE_AGENT); }
__device__ __forceinline__ unsigned xb_xcc_id() { return (unsigned)__builtin_amdgcn_s_getreg((3 << 11) | 20) & 0xFu; }
#define XB_SPIN(cond, bar) do { unsigned _sp = 0; while (cond) { __builtin_amdgcn_s_sleep(1); \
    if ((++_sp & 255u) == 0u) { if (xb_ld(&(bar)[XB_TMO])) break; if (_sp > XB_SPIN_CAP) { atomicAdd(&(bar)[XB_TMO], 1u); break; } } } } while (0)

struct XcdBarrier {
    unsigned* bar; unsigned x;
    volatile LAS unsigned* st;
};

__device__ __forceinline__ XcdBarrier xcd_barrier_post(unsigned* bar, volatile LAS unsigned* st) {
    XcdBarrier b; b.bar = bar; b.x = xb_xcc_id(); b.st = st;
    if (threadIdx.x == 0) (void)xb_add(&bar[XB_XCNT(b.x)], 1u);
    return b;
}
__device__ __forceinline__ void xcd_barrier_complete(unsigned* bar, unsigned x, unsigned& nloc, unsigned& nx) {
    const unsigned G = gridDim.x * gridDim.y * gridDim.z;
    unsigned sum, cnt, mine, sp = 0u;
    for (;;) {
        sum = 0u; cnt = 0u; mine = 0u;
#pragma unroll
        for (unsigned j = 0; j < 16; ++j) { const unsigned c = xb_ld(&bar[XB_XCNT(j)]); sum += c; cnt += (c > 0u) ? 1u : 0u; mine = (j == x) ? c : mine; }
        if (sum == G) break;
        __builtin_amdgcn_s_sleep(1);
        if ((++sp & 255u) == 0u) { if (xb_ld(&bar[XB_TMO])) break; if (sp > XB_SPIN_CAP) { atomicAdd(&bar[XB_TMO], 1u); break; } }
    }
    nloc = mine > 0u ? mine : 1u; nx = cnt > 0u ? cnt : 1u;
}

__device__ __forceinline__ void xcd_barrier(const XcdBarrier& b) {
    asm volatile("s_waitcnt vmcnt(0)" ::: "memory");
    __syncthreads();
    if (threadIdx.x == 0) {
        unsigned* bar = b.bar;
        __builtin_amdgcn_s_waitcnt(0);
        unsigned nloc = b.st[0], nx = b.st[1];
        if (nloc == 0u) { xcd_barrier_complete(bar, b.x, nloc, nx); b.st[0] = nloc; b.st[1] = nx; }
        const unsigned old = xb_add(&bar[XB_XSUB(b.x)], 1u);
        const unsigned gen = old / nloc;
        if (old + 1u == (gen + 1u) * nloc) {
            __builtin_amdgcn_fence(__ATOMIC_RELEASE, "agent");
            asm volatile("s_waitcnt vmcnt(0)" ::: "memory");
            const unsigned og = xb_add(&bar[XB_TOP], 1u);
            const unsigned tg = og / nx;
            if (og + 1u == (tg + 1u) * nx) xb_add(&bar[XB_TOPGEN], 1u);
            else XB_SPIN(xb_ld(&bar[XB_TOPGEN]) == tg, bar);
            __builtin_amdgcn_fence(__ATOMIC_ACQUIRE, "agent");
            xb_add(&bar[XB_XGEN(b.x)], 1u);
            asm volatile("s_waitcnt vmcnt(0)" ::: "memory");
        } else {
            XB_SPIN(xb_ld(&bar[XB_XGEN(b.x)]) == gen, bar);
            __builtin_amdgcn_fence(__ATOMIC_ACQUIRE, "agent");
            asm volatile("s_waitcnt vmcnt(0)" ::: "memory");
        }
    }
    __syncthreads();
}

struct Params {
    const float *x, *mem, *rel_bias, *lb_logits, *gains, *w_in, *hg_norm, *w_out, *w_cq, *w_ckv, *w_co, *w_gu, *w_dn;
    float* out; unsigned char* ws; int ph_lo, ph_hi;
};

__device__ __forceinline__ void transpose_item(const float* W, const float* gain, int K, int N, bf16* WT, int k0, int n0, LAS float* scr, int lane) {
#pragma unroll 8
    for (int i = 0; i < 32; ++i) { const int kk = 2 * i + (lane >> 5); const float g = gain ? gain[k0 + kk] : 1.0f; scr[kk * 33 + (lane & 31)] = W[(size_t)(k0 + kk) * N + n0 + (lane & 31)] * g; }
    LDS_WAIT(); asm volatile("" ::: "memory");
    const int c = lane & 7;
#pragma unroll
    for (int j = 0; j < 4; ++j) { const int n = (lane >> 3) + 8 * j; const LAS float* s = scr + (8 * c) * 33 + n;
        v4u o; o.x = pk2(s[0 * 33], s[1 * 33]); o.y = pk2(s[2 * 33], s[3 * 33]); o.z = pk2(s[4 * 33], s[5 * 33]); o.w = pk2(s[6 * 33], s[7 * 33]);
        *(v4u*)(WT + (size_t)n * K + k0 + 8 * c) = o; }
    LDS_WAIT(); asm volatile("" ::: "memory");
}
constexpr int I_IN = (D / 64) * (INC / 32), I_SQ = (D / 64) * (D / 32), I_CKV = (D / 64) * (NCKV / 32), I_GU = (D / 64) * (NGU / 32), I_DN = (DFF / 64) * (D / 32);
constexpr int ITEMS_L = I_IN + 3 * I_SQ + I_CKV + I_GU + I_DN;

__device__ __forceinline__ int rel_bucket(int dist) {
    if (dist < 16) return dist;
    const float df = (float)dist;
    int large = 16 + (int)(logf(df / 16.0f) / 4.852030263919617f * 16.0f);
    return large < 31 ? large : 31;
}

__device__ __forceinline__ void row_prep(const float* src, float* cpy, bf16* dstb, float* rstd, int lane) {
    const f32x4* s4 = (const f32x4*)src + lane; f32x4 v[8]; float ss = 0.f;
#pragma unroll
    for (int j = 0; j < 8; ++j) { v[j] = s4[64 * j]; ss += (v[j][0] * v[j][0] + v[j][1] * v[j][1]) + (v[j][2] * v[j][2] + v[j][3] * v[j][3]); }
    ss = wave_sum(ss);
    if (lane == 0) *rstd = 1.0f / sqrtf(ss * (1.0f / D) + RMS_EPS);
    v2u* d2 = (v2u*)dstb + lane;
#pragma unroll
    for (int j = 0; j < 8; ++j) { if (cpy) ((f32x4*)cpy + lane)[64 * j] = v[j]; v2u w; w.x = pk2(v[j][0], v[j][1]); w.y = pk2(v[j][2], v[j][3]); d2[64 * j] = w; }
}

__device__ __forceinline__ void ph_prologue(const Params& p, LAS unsigned char* lds) {
    const int tid = opq_tid(), lane = tid & 63, wave = tid >> 6;
    const int gw = opq_s(blockIdx.x) * 8 + wave, ngw = opq_s(gridDim.x) * 8;
    LAS float* scr = (LAS float*)(lds + wave * 16384);
    unsigned char* ws = opq_ptr(p.ws);
    for (int it = gw; it < DEPTH * ITEMS_L; it += ngw) {
        const int l = it / ITEMS_L; int r = it % ITEMS_L;
        const float* g = p.gains + (size_t)l * 7 * D;
        const float* W; const float* gain; int K, N, mode = 0; bf16* WT;
        if (r < I_IN) { W = p.w_in + (size_t)l * D * INC; gain = g; K = D; N = INC; WT = (bf16*)(ws + WS_WIN) + (size_t)l * INC * D; }
        else if ((r -= I_IN) < I_SQ) { W = p.w_out + (size_t)l * D * D; gain = nullptr; K = D; N = D; WT = (bf16*)(ws + WS_WOUT) + (size_t)l * D * D; }
        else if ((r -= I_SQ) < I_SQ) { W = p.w_cq + (size_t)l * D * D; gain = g + 2 * D; K = D; N = D; WT = (bf16*)(ws + WS_WCQ) + (size_t)l * D * D; }
        else if ((r -= I_SQ) < I_CKV) { W = p.w_ckv + (size_t)l * D * NCKV; gain = g + 3 * D; K = D; N = NCKV; WT = (bf16*)(ws + WS_WCKV) + (size_t)l * NCKV * D; }
        else if ((r -= I_CKV) < I_SQ) { W = p.w_co + (size_t)l * D * D; gain = nullptr; K = D; N = D; WT = (bf16*)(ws + WS_WCO) + (size_t)l * D * D; }
        else if ((r -= I_SQ) < I_GU) { W = p.w_gu + (size_t)l * D * NGU; gain = g + 5 * D; K = D; N = NGU; mode = 1; WT = (bf16*)(ws + WS_WGU) + (size_t)l * NGU * D; }
        else { r -= I_GU; W = p.w_dn + (size_t)l * DFF * D; gain = nullptr; K = DFF; N = D; WT = (bf16*)(ws + WS_WDN) + (size_t)l * D * DFF; }
        const int nblk = N / 32, kb = r / nblk, nb = r % nblk, k0 = kb * 64, n0 = nb * 32;
        int orow = n0;
        if (mode == 1) orow = (n0 < DFF) ? 256 * (n0 / 128) + (n0 % 128) : 256 * ((n0 - DFF) / 128) + 128 + ((n0 - DFF) % 128);
        transpose_item(W, gain, K, N, WT + (size_t)orow * K, k0, n0, scr, lane);
    }
    const int gt = blockIdx.x * 512 + tid, ngt = gridDim.x * 512;
    float* lb = (float*)(ws + WS_LB); float* bt = (float*)(ws + WS_BIAS);
    for (int c = gt; c < 1024; c += ngt) {
        float e[4]; float mx = -3e38f;
        for (int l = 0; l < 4; ++l) { e[l] = p.lb_logits[l * 1024 + c]; mx = fmaxf(mx, e[l]); }
        float sum = 0.f; for (int l = 0; l < 4; ++l) { e[l] = expf(e[l] - mx); sum += e[l]; }
        float cum = 0.f; for (int l = 0; l < 4; ++l) { lb[l * 1024 + c] = cum; cum += e[l] / sum; }
    }
    for (int i = gt; i < 3 * 132 * 8; i += ngt) {
        const int h = i & 7, j = (i >> 3) % 132, g = (i >> 3) / 132;
        float v = 0.f; if (j <= 128) v = p.rel_bias[rel_bucket(j << (2 * g)) * 8 + h];
        bt[i] = v;
    }
    for (int row = gw; row < M; row += ngw) row_prep(p.x + (size_t)row * D, p.out + (size_t)row * D, (bf16*)(ws + WS_XB) + (size_t)row * D, (float*)(ws + WS_RSTDX) + row, lane);
    for (int row = gw; row < MROWS; row += ngw) row_prep(p.mem + (size_t)row * D, nullptr, (bf16*)(ws + WS_MEMB) + (size_t)row * D, (float*)(ws + WS_RSTDM) + row, lane);
}

__device__ __forceinline__ void ph_resnorm(const Params& p_, const float* gain) {
    struct { unsigned char* ws; float* out; } p; p.ws = opq_ptr(p_.ws); p.out = p_.out;
    const int tid = opq_tid(), lane = tid & 63, wave = tid >> 6;
    const int gw = opq_s(blockIdx.x) * 8 + wave, ngw = opq_s(gridDim.x) * 8;
    const float* Y = (const float*)(p.ws + WS_Y); const float* part = (const float*)(p.ws + WS_PART);
    bf16* xb = (bf16*)(p.ws + WS_XB); float* rstdx = (float*)(p.ws + WS_RSTDX);
    for (int row = gw; row < M; row += ngw) {
        float ss = (lane < 32) ? part[(size_t)row * 32 + lane] : 0.f; ss = wave_sum(ss);
        const float ry = 1.0f / sqrtf(ss * (1.0f / D) + RMS_EPS);
        const f32x4* y4 = (const f32x4*)(Y + (size_t)row * D) + lane; f32x4* x4 = (f32x4*)(p.out + (size_t)row * D) + lane; const f32x4* g4 = (const f32x4*)gain + lane;
        v2u* d2 = (v2u*)(xb + (size_t)row * D) + lane; float s2 = 0.f;
#pragma unroll
        for (int j = 0; j < 8; ++j) { const f32x4 xn = x4[64 * j] + y4[64 * j] * ry * g4[64 * j]; x4[64 * j] = xn;
            s2 += (xn[0] * xn[0] + xn[1] * xn[1]) + (xn[2] * xn[2] + xn[3] * xn[3]); v2u w; w.x = pk2(xn[0], xn[1]); w.y = pk2(xn[2], xn[3]); d2[64 * j] = w; }
        s2 = wave_sum(s2);
        if (lane == 0) rstdx[row] = 1.0f / sqrtf(s2 * (1.0f / D) + RMS_EPS);
    }
}

__device__ __forceinline__ void ph_attn_naive(const Params& p_, LAS unsigned char* lds) {
    struct { unsigned char* ws; } p; p.ws = opq_ptr(p_.ws);
    const int tid = opq_tid(), lane = tid & 63, wave = tid >> 6;
    const int gw = opq_s(blockIdx.x) * 8 + wave, ngw = opq_s(gridDim.x) * 8;
    LAS float* qs = (LAS float*)(lds + wave * 2560); LAS float* Ls = qs + 128;
    const bf16* proj = (const bf16*)(p.ws + WS_PROJ); const float* bt = (const float*)(p.ws + WS_BIAS); bf16* mix = (bf16*)(p.ws + WS_MIX);
    const float scale = 0.08838834764831845f;
    for (int item = gw; item < M * 8; item += ngw) {
        const int row = item >> 3, h = item & 7, b = row >> 13, t = row & 8191;
        { const unsigned qq = *(const unsigned*)(proj + (size_t)row * INC + h * 128 + 2 * lane); qs[2 * lane] = bf2f(qq & 0xffffu); qs[2 * lane + 1] = bf2f(qq >> 16); }
        LDS_WAIT(); asm volatile("" ::: "memory");
        float lg[9]; float mx = -3e38f;
#pragma unroll
        for (int g = 0; g < 3; ++g)
#pragma unroll
            for (int jj = 0; jj < 3; ++jj) {
                const int j = lane + 64 * jj; float v = -3e38f;
                if (j <= 128) { const int tk = t - (j << (2 * g));
                    if (tk >= 0) { const v4u* kp = (const v4u*)(proj + (size_t)(b * SEQ + tk) * INC + 1024 + h * 128); float dot = 0.f;
                        for (int c = 0; c < 16; ++c) { const v4u kv = kp[c]; const LAS float* q = qs + 8 * c;
                            dot += bf2f(kv.x & 0xffffu) * q[0] + bf2f(kv.x >> 16) * q[1] + bf2f(kv.y & 0xffffu) * q[2] + bf2f(kv.y >> 16) * q[3]
                                 + bf2f(kv.z & 0xffffu) * q[4] + bf2f(kv.z >> 16) * q[5] + bf2f(kv.w & 0xffffu) * q[6] + bf2f(kv.w >> 16) * q[7]; }
                        v = dot * scale + bt[(g * 132 + j) * 8 + h]; } }
                lg[g * 3 + jj] = v; mx = fmaxf(mx, v); }
        mx = wave_max(mx);
        float sum = 0.f;
#pragma unroll
        for (int g = 0; g < 3; ++g)
#pragma unroll
            for (int jj = 0; jj < 3; ++jj) { const int j = lane + 64 * jj; const float v = lg[g * 3 + jj]; const float pj = (v > -1e37f) ? __expf(v - mx) : 0.f; sum += pj; if (j <= 128) Ls[g * 132 + j] = pj; }
        sum = wave_sum(sum);
        LDS_WAIT(); asm volatile("" ::: "memory");
        float o0 = 0.f, o1 = 0.f;
        for (int g = 0; g < 3; ++g) { const int jm = (t >> (2 * g)) < 128 ? (t >> (2 * g)) : 128;
            for (int j = 0; j <= jm; ++j) { const float pj = Ls[g * 132 + j];
                const unsigned vv = *(const unsigned*)(proj + (size_t)(b * SEQ + t - (j << (2 * g))) * INC + 2048 + h * 128 + 2 * lane);
                o0 += pj * bf2f(vv & 0xffffu); o1 += pj * bf2f(vv >> 16); } }
        const float inv = 1.0f / sum;
        *(unsigned*)(mix + (size_t)row * D + h * 128 + 2 * lane) = pk2(o0 * inv, o1 * inv);
        LDS_WAIT(); asm volatile("" ::: "memory");
    }
}

__device__ __forceinline__ void ph_hgrn_naive(const Params& p_, int l, LAS unsigned char* lds) {
    struct { unsigned char* ws; } p; p.ws = opq_ptr(p_.ws);
    const int tid = opq_tid(), v = tid >> 2, kq = tid & 3;
    LAS float* Fs = (LAS float*)lds; LAS float* Qs = Fs + 16 * 128; LAS float* Vs = Qs + 16 * 128;
    const bf16* proj = (const bf16*)(p.ws + WS_PROJ); const float* lb = (const float*)(p.ws + WS_LB) + l * 1024; float* hgo = (float*)(p.ws + WS_HG);
    for (int unit = blockIdx.x; unit < 16; unit += gridDim.x) {
        const int b = unit >> 3, h = unit & 7;
        float S[32];
#pragma unroll
        for (int i = 0; i < 32; ++i) S[i] = 0.f;
        for (int t0 = 0; t0 < SEQ; t0 += 16) {
            __syncthreads();
#pragma unroll
            for (int i = 0; i < 4; ++i) { const int e = tid + 512 * i, ts = e >> 7, k = e & 127; const size_t ro = (size_t)(b * SEQ + t0 + ts) * INC + h * 128 + k;
                const float fz = bf2f(proj[ro + 3072]), iv = bf2f(proj[ro + 4096]), qz = bf2f(proj[ro + 5120]);
                const float lbv = lb[h * 128 + k]; Fs[e] = lbv + (1.0f - lbv) / (1.0f + __expf(-fz)); Qs[e] = silu_f(qz); Vs[e] = iv; }
            __syncthreads();
            for (int ts = 0; ts < 16; ++ts) {
                const float ivv = Vs[ts * 128 + v]; float acc = 0.f;
#pragma unroll
                for (int i = 0; i < 32; ++i) { const float f = Fs[ts * 128 + kq * 32 + i]; S[i] = f * S[i] + (1.0f - f) * ivv; acc += Qs[ts * 128 + kq * 32 + i] * S[i]; }
                acc += __shfl_xor(acc, 1); acc += __shfl_xor(acc, 2);
                if (kq == 0) hgo[(size_t)(b * SEQ + t0 + ts) * 1024 + h * 128 + v] = acc;
            }
        }
    }
    __syncthreads();
}
__device__ __forceinline__ void ph_hg_finish(const Params& p_, int l) {
    struct { unsigned char* ws; const float* hg_norm; } p; p.ws = opq_ptr(p_.ws); p.hg_norm = p_.hg_norm;
    const int tid = opq_tid(), lane = tid & 63, wave = tid >> 6;
    const int gw = opq_s(blockIdx.x) * 8 + wave, ngw = opq_s(gridDim.x) * 8;
    const bf16* proj = (const bf16*)(p.ws + WS_PROJ); const float* hgo = (const float*)(p.ws + WS_HG); bf16* mix = (bf16*)(p.ws + WS_MIX);
    const float* hgain = p.hg_norm + l * 1024;
    for (int item = gw; item < M * 8; item += ngw) {
        const int row = item >> 3, h = item & 7;
        const float o0 = hgo[(size_t)row * 1024 + h * 128 + 2 * lane], o1 = hgo[(size_t)row * 1024 + h * 128 + 2 * lane + 1];
        const float ss = wave_sum(o0 * o0 + o1 * o1); const float r = 1.0f / sqrtf(ss * (1.0f / 128.0f) + RMS_EPS);
        const unsigned gz = *(const unsigned*)(proj + (size_t)row * INC + 6144 + h * 128 + 2 * lane);
        const float g0 = hgain[h * 128 + 2 * lane], g1 = hgain[h * 128 + 2 * lane + 1];
        *(unsigned*)(mix + (size_t)row * D + 1024 + h * 128 + 2 * lane) = pk2(o0 * r * g0 * silu_f(bf2f(gz & 0xffffu)), o1 * r * g1 * silu_f(bf2f(gz >> 16)));
    }
}

__device__ __forceinline__ void ph_cross_naive(const Params& p_, int l, LAS unsigned char* lds) {
    struct { unsigned char* ws; } p; p.ws = opq_ptr(p_.ws);
    const int tid = opq_tid(), lane = tid & 63, wave = tid >> 6;
    const int gw = opq_s(blockIdx.x) * 8 + wave, ngw = opq_s(gridDim.x) * 8;
    LAS float* qs = (LAS float*)(lds + wave * 4096); LAS float* Ps = qs + 512;
    const bf16* cq = (const bf16*)(p.ws + WS_PROJ); const bf16* ckv = (const bf16*)(p.ws + WS_CKV) + l * NCKV; bf16* mix = (bf16*)(p.ws + WS_MIX);
    const float scale = 0.04419417382415922f;
    for (int item = gw; item < M * 4; item += ngw) {
        const int row = item >> 2, h = item & 3, b = row >> 13;
        { const v4u qq = *(const v4u*)(cq + (size_t)row * D + h * 512 + 8 * lane); LAS float* q = qs + 8 * lane;
          q[0] = bf2f(qq.x & 0xffffu); q[1] = bf2f(qq.x >> 16); q[2] = bf2f(qq.y & 0xffffu); q[3] = bf2f(qq.y >> 16); q[4] = bf2f(qq.z & 0xffffu); q[5] = bf2f(qq.z >> 16); q[6] = bf2f(qq.w & 0xffffu); q[7] = bf2f(qq.w >> 16); }
        LDS_WAIT(); asm volatile("" ::: "memory");
        float lg[4]; float mx = -3e38f;
#pragma unroll
        for (int i = 0; i < 4; ++i) { const int m = lane + 64 * i; const v4u* kp = (const v4u*)(ckv + (size_t)(b * NMEM + m) * (DEPTH * NCKV) + h * 512); float dot = 0.f;
            for (int c = 0; c < 64; ++c) { const v4u kv = kp[c]; const LAS float* q = qs + 8 * c;
                dot += bf2f(kv.x & 0xffffu) * q[0] + bf2f(kv.x >> 16) * q[1] + bf2f(kv.y & 0xffffu) * q[2] + bf2f(kv.y >> 16) * q[3]
                     + bf2f(kv.z & 0xffffu) * q[4] + bf2f(kv.z >> 16) * q[5] + bf2f(kv.w & 0xffffu) * q[6] + bf2f(kv.w >> 16) * q[7]; }
            lg[i] = dot * scale; mx = fmaxf(mx, lg[i]); }
        mx = wave_max(mx); float sum = 0.f;
#pragma unroll
        for (int i = 0; i < 4; ++i) { const float pj = __expf(lg[i] - mx); sum += pj; Ps[lane + 64 * i] = pj; }
        sum = wave_sum(sum);
        LDS_WAIT(); asm volatile("" ::: "memory");
        float o[8];
#pragma unroll
        for (int i = 0; i < 8; ++i) o[i] = 0.f;
        for (int m = 0; m < NMEM; ++m) { const float pm = Ps[m]; const v4u vv = *(const v4u*)(ckv + (size_t)(b * NMEM + m) * (DEPTH * NCKV) + 2048 + h * 512 + 8 * lane);
            o[0] += pm * bf2f(vv.x & 0xffffu); o[1] += pm * bf2f(vv.x >> 16); o[2] += pm * bf2f(vv.y & 0xffffu); o[3] += pm * bf2f(vv.y >> 16);
            o[4] += pm * bf2f(vv.z & 0xffffu); o[5] += pm * bf2f(vv.z >> 16); o[6] += pm * bf2f(vv.w & 0xffffu); o[7] += pm * bf2f(vv.w >> 16); }
        const float inv = 1.0f / sum; v4u w; w.x = pk2(o[0] * inv, o[1] * inv); w.y = pk2(o[2] * inv, o[3] * inv); w.z = pk2(o[4] * inv, o[5] * inv); w.w = pk2(o[6] * inv, o[7] * inv);
        *(v4u*)(mix + (size_t)row * D + h * 512 + 8 * lane) = w;
        LDS_WAIT(); asm volatile("" ::: "memory");
    }
}


__device__ __forceinline__ unsigned pk2_hw(float lo, float hi) { unsigned r; asm volatile("v_cvt_pk_bf16_f32 %0, %1, %2" : "=v"(r) : "v"(lo), "v"(hi)); return r; }
__device__ __forceinline__ void ph_cross(const Params& p_, int l, LAS unsigned char* lds) {
    unsigned char* ws = opq_ptr(p_.ws);
    const int tid = opq_tid(), lane = tid & 63, wave = __builtin_amdgcn_readfirstlane(tid >> 6), q15 = lane & 15, g = lane >> 4;
    const bf16* cq = (const bf16*)(ws + WS_PROJ); const bf16* ck = (const bf16*)(ws + WS_CKV); const bf16* cvt = (const bf16*)(ws + WS_CVT); bf16* mix = (bf16*)(ws + WS_MIX);
    const float sc2 = 0.04419417382415922f * 1.4426950408889634f;
    const int nb = opq_s(gridDim.x);
    for (int unit = opq_s(blockIdx.x); unit < 512; unit += nb) {
        const int b = unit >> 8, h = (unit >> 6) & 3, qt = unit & 63;
        const int row0 = b * SEQ + qt * 128 + wave * 16;
        const bf16* kbase = ck + (size_t)(b * NMEM) * (DEPTH * NCKV) + l * NCKV + h * 512;
        const bf16* vbase = cvt + (size_t)(((l * 2 + b) * 4 + h) * 512) * 256;
#define CR_ISSUE_K(c, bo) do { int ln_ = lane; asm volatile("" : "+v"(ln_)); const char* kb_ = (const char*)(kbase + 128 * (c)); _Pragma("unroll") for (int i_ = 0; i_ < 8; ++i_) { const int pi_ = wave * 8 + i_, r_ = 4 * pi_ + (ln_ >> 4), ch_ = (ln_ & 15) ^ (r_ & 15); \
            const unsigned vo_ = (unsigned)r_ * (unsigned)(DEPTH * NCKV * 2) + (unsigned)ch_ * 16u; \
            __builtin_amdgcn_global_load_lds((const unsigned*)(kb_ + vo_), (LAS unsigned*)(lds + (bo) + pi_ * 1024), 16, 0, 0); } } while (0)
#define CR_ISSUE_V(cv, bo) do { int ln_ = lane; asm volatile("" : "+v"(ln_)); const char* vb_ = (const char*)(vbase + (size_t)(128 * (cv)) * 256); _Pragma("unroll") for (int i_ = 0; i_ < 8; ++i_) { const int pi_ = wave * 8 + i_, r_ = 2 * pi_ + (ln_ >> 5), ch_ = (ln_ & 31) ^ (r_ & 15); \
            const unsigned vo_ = (unsigned)r_ * 512u + (unsigned)ch_ * 16u; \
            __builtin_amdgcn_global_load_lds((const unsigned*)(vb_ + vo_), (LAS unsigned*)(lds + (bo) + pi_ * 1024), 16, 0, 0); } } while (0)
#define CR_SYNC() do { asm volatile("s_waitcnt vmcnt(0) lgkmcnt(0)" ::: "memory"); __builtin_amdgcn_s_barrier(); asm volatile("" ::: "memory"); } while (0)
        const bf16* qp = cq + (size_t)(row0 + q15) * D + h * 512 + g * 8;
        bf16x8 Qa[4], Qb[4];
#pragma unroll
        for (int ks = 0; ks < 4; ++ks) Qa[ks] = *(const bf16x8*)(qp + ks * 32);
        f32x4 S[16];
#pragma unroll
        for (int kt = 0; kt < 16; ++kt) S[kt] = (f32x4){0.f, 0.f, 0.f, 0.f};
        CR_ISSUE_K(0, 0); CR_SYNC();
#define CR_QK(Q, bo) do { _Pragma("unroll") for (int kt = 0; kt < 16; ++kt) _Pragma("unroll") for (int ks = 0; ks < 4; ++ks) { \
            const bf16x8 a_ = *(const LAS bf16x8*)(lds + (bo) + (16 * kt + q15) * 256 + (((4 * ks + g) ^ q15) * 16)); \
            S[kt] = __builtin_amdgcn_mfma_f32_16x16x32_bf16(a_, Q[ks], S[kt], 0, 0, 0); } } while (0)
#define CR_LDQ(Q, c) do { _Pragma("unroll") for (int ks = 0; ks < 4; ++ks) Q[ks] = *(const bf16x8*)(qp + 128 * (c) + ks * 32); } while (0)
        CR_ISSUE_K(1, 65536); CR_LDQ(Qb, 1); CR_QK(Qa, 0); CR_SYNC();
        CR_ISSUE_K(2, 0); CR_LDQ(Qa, 2); CR_QK(Qb, 65536); CR_SYNC();
        CR_ISSUE_K(3, 65536); CR_LDQ(Qb, 3); CR_QK(Qa, 0); CR_SYNC();
        CR_ISSUE_V(0, 0); CR_QK(Qb, 65536); CR_SYNC();
#undef CR_QK
#undef CR_LDQ
        float mx = -3e38f;
#pragma unroll
        for (int kt = 0; kt < 16; ++kt) mx = fmaxf(mx, fmaxf(fmaxf(S[kt][0], S[kt][1]), fmaxf(S[kt][2], S[kt][3])));
        mx = fmaxf(mx, __shfl_xor(mx, 16)); mx = fmaxf(mx, __shfl_xor(mx, 32));
        float sum = 0.f; const float mb = mx * sc2;
#pragma unroll
        for (int kt = 0; kt < 16; ++kt)
#pragma unroll
            for (int r = 0; r < 4; ++r) { const float e = __builtin_amdgcn_exp2f(S[kt][r] * sc2 - mb); S[kt][r] = e; sum += e; }
        sum += __shfl_xor(sum, 16); sum += __shfl_xor(sum, 32);
        const float inv = 1.0f / sum;
        bf16x8 Pf[8];
#pragma unroll
        for (int s = 0; s < 8; ++s) { v4u w; w.x = pk2_hw(S[2 * s][0], S[2 * s][1]); w.y = pk2_hw(S[2 * s][2], S[2 * s][3]); w.z = pk2_hw(S[2 * s + 1][0], S[2 * s + 1][1]); w.w = pk2_hw(S[2 * s + 1][2], S[2 * s + 1][3]);
            Pf[s] = __builtin_bit_cast(bf16x8, w); }
        bf16* orow = mix + (size_t)(row0 + q15) * D + h * 512 + 4 * g;
#pragma unroll
        for (int cv = 0; cv < 4; ++cv) {
            const int bo = ((cv + 4) & 1) * 65536, bn = ((cv + 5) & 1) * 65536;
            if (cv < 3) CR_ISSUE_V(cv + 1, bn);
#pragma unroll
            for (int dt = 0; dt < 8; ++dt) {
                f32x4 o = (f32x4){0.f, 0.f, 0.f, 0.f};
#pragma unroll
                for (int s = 0; s < 8; ++s) {
                    const bf16x8 a = *(const LAS bf16x8*)(lds + bo + (16 * dt + q15) * 512 + (((4 * s + g) ^ q15) * 16));
                    o = __builtin_amdgcn_mfma_f32_16x16x32_bf16(a, Pf[s], o, 0, 0, 0); }
                v2u w; w.x = pk2_hw(o[0] * inv, o[1] * inv); w.y = pk2_hw(o[2] * inv, o[3] * inv);
                *(v2u*)(orow + 128 * cv + 16 * dt) = w;
            }
            CR_SYNC();
        }
#undef CR_ISSUE_K
#undef CR_ISSUE_V
#undef CR_SYNC
    }
}


constexpr int AT_BIAS_OFF = RING_BYTES + 1024;
constexpr size_t WS_OG = WS_Y;
constexpr size_t WS_LSE = WS_Y + (size_t)3 * M * 1024 * 2;
static_assert(WS_LSE + (size_t)3 * M * 8 * 4 <= WS_MIX, "attention partials fit in the Y region");
__device__ __forceinline__ v2u tr_read_b64(unsigned addr) { v2u r; asm volatile("ds_read_b64_tr_b16 %0, %1" : "=v"(r) : "v"(addr) : "memory"); return r; }
__device__ __forceinline__ void ph_attn(const Params& p_, LAS unsigned char* lds) {
    unsigned char* ws = opq_ptr(p_.ws);
    const int tid = opq_tid(), lane = tid & 63, wave = __builtin_amdgcn_readfirstlane(tid >> 6), q15 = lane & 15, g4 = lane >> 4;
    const bf16* proj = (const bf16*)(ws + WS_PROJ); bf16* og = (bf16*)(ws + WS_OG); float* lse = (float*)(ws + WS_LSE);
    { const float* bt = (const float*)(ws + WS_BIAS); LAS float* bl = (LAS float*)(lds + AT_BIAS_OFF); for (int i = tid; i < 3 * 132 * 8; i += 512) bl[i] = bt[i] * 1.4426950408889634f; }
    __syncthreads();
    const LAS float* bl = (const LAS float*)(lds + AT_BIAS_OFF);
    const float sc2 = 0.08838834764831845f * 1.4426950408889634f;
    const int nb_ = opq_s(gridDim.x);
    int u = opq_s(blockIdx.x);
#define AT_DECODE(u_) const int g = (u_) >> 10, v_ = (u_) & 1023, b = v_ >> 9, h = (v_ >> 6) & 7, rem_ = v_ & 63, sh = 2 * g, res = rem_ >> (6 - sh), nb = rem_ & ((64 >> sh) - 1); (void)g; (void)b; (void)h; (void)res; (void)nb; (void)sh;
#define AT_ISSUE(u_, imgoff, colbase, SRCCH) do { AT_DECODE(u_) int ln_ = lane; asm volatile("" : "+v"(ln_)); const char* pb_ = (const char*)(proj + (size_t)b * SEQ * INC + (colbase) + h * 128); \
        _Pragma("unroll") for (int i_ = 0; i_ < 8; ++i_) { const int pi_ = wave * 8 + i_, kj_ = 4 * pi_ + (ln_ >> 4), pp_ = ln_ & 15; int sub_ = (nb - 1) * 128 + kj_; sub_ = sub_ < 0 ? 0 : sub_; \
            const unsigned vo_ = (unsigned)((sub_ << sh) + res) * (unsigned)(INC * 2) + (unsigned)(SRCCH) * 16u; \
            __builtin_amdgcn_global_load_lds((const unsigned*)(pb_ + vo_), (LAS unsigned*)(lds + (imgoff) + pi_ * 1024), 16, 0, 0); } } while (0)
#define AT_ISSUE_K(u_) AT_ISSUE(u_, 0, 1024, (pp_ ^ (kj_ & 15)))
#define AT_ISSUE_V(u_) AT_ISSUE(u_, 65536, 2048, ((((pp_ >> 1) ^ (kj_ & 7)) << 1) | (pp_ & 1)))
#define AT_LDQ(u_) do { AT_DECODE(u_) const bf16* qp_ = proj + (size_t)(b * SEQ + (((nb * 128 + 16 * wave + q15) << sh) + res)) * INC + h * 128 + g4 * 8; \
        _Pragma("unroll") for (int ks = 0; ks < 4; ++ks) Q[ks] = *(const bf16x8*)(qp_ + ks * 32); } while (0)
#define AT_SYNC() do { asm volatile("s_waitcnt vmcnt(0) lgkmcnt(0)" ::: "memory"); __builtin_amdgcn_s_barrier(); asm volatile("" ::: "memory"); } while (0)
    bf16x8 Q[4];
    if (u < 3072) { AT_ISSUE_K(u); AT_LDQ(u); }
    AT_SYNC();
    if (u < 3072) AT_ISSUE_V(u);
    for (; u < 3072; u += nb_) {
        AT_DECODE(u)
        const int un = u + nb_; const bool has_next = un < 3072;
        f32x4 S[9];
#pragma unroll
        for (int kt = 0; kt < 9; ++kt) S[kt] = (f32x4){0.f, 0.f, 0.f, 0.f};
        { const unsigned kb = (unsigned)(wave * 4096 + q15 * 256);
#pragma unroll
          for (int ks = 0; ks < 4; ++ks) { const unsigned ka = kb + (unsigned)(((4 * ks + g4) ^ q15) * 16);
#pragma unroll
            for (int kt = 0; kt < 9; ++kt) { const bf16x8 a = *(const LAS bf16x8*)(lds + ka + kt * 4096); S[kt] = __builtin_amdgcn_mfma_f32_16x16x32_bf16(a, Q[ks], S[kt], 0, 0, 0); } } }
        float mx = -3e38f;
#pragma unroll
        for (int kt = 0; kt < 9; ++kt)
#pragma unroll
            for (int r = 0; r < 4; ++r) { const int dist = 128 + q15 - 16 * kt - 4 * g4 - r; const int kj = 16 * (wave + kt) + 4 * g4 + r;
                bool ok = (nb > 0) || (kj >= 128); if (kt == 0) ok = ok && (dist <= 128); if (kt == 8) ok = ok && (dist >= 0);
                const int dc = dist < 0 ? 0 : (dist > 128 ? 128 : dist);
                const float sv = ok ? S[kt][r] * sc2 + bl[(g * 132 + dc) * 8 + h] : -3e38f; S[kt][r] = sv; mx = fmaxf(mx, sv); }
        mx = fmaxf(mx, __shfl_xor(mx, 16)); mx = fmaxf(mx, __shfl_xor(mx, 32));
        float sum = 0.f;
#pragma unroll
        for (int kt = 0; kt < 9; ++kt)
#pragma unroll
            for (int r = 0; r < 4; ++r) { const float sv = S[kt][r]; const float e = (sv > -1e37f) ? __builtin_amdgcn_exp2f(sv - mx) : 0.f; S[kt][r] = e; sum += e; }
        sum += __shfl_xor(sum, 16); sum += __shfl_xor(sum, 32);
        bf16x8 Pf[5];
#pragma unroll
        for (int s = 0; s < 5; ++s) { v4u w; w.x = pk2_hw(S[2 * s][0], S[2 * s][1]); w.y = pk2_hw(S[2 * s][2], S[2 * s][3]);
            if (s < 4) { w.z = pk2_hw(S[2 * s + 1][0], S[2 * s + 1][1]); w.w = pk2_hw(S[2 * s + 1][2], S[2 * s + 1][3]); } else { w.z = 0u; w.w = 0u; }
            Pf[s] = __builtin_bit_cast(bf16x8, w); }
        AT_SYNC();
        if (has_next) { AT_ISSUE_K(un); AT_LDQ(un); }
        f32x4 O[8];
#pragma unroll
        for (int dt = 0; dt < 8; ++dt) O[dt] = (f32x4){0.f, 0.f, 0.f, 0.f};
        { const int qp4 = q15 >> 2, p4 = q15 & 3, x = 4 * (g4 & 1) + qp4;
          const unsigned vb = (unsigned)(65536 + wave * 4096 + (4 * g4 + qp4) * 256 + 8 * p4);
#pragma unroll
          for (int s = 0; s < 5; ++s) {
              v2u lo[8], hi[8];
#pragma unroll
              for (int dt = 0; dt < 8; ++dt) { const unsigned a0 = vb + (unsigned)(((dt ^ x) << 5) + s * 8192); lo[dt] = tr_read_b64(a0); if (s < 4) hi[dt] = tr_read_b64(a0 + 4096u); else hi[dt] = (v2u){0u, 0u}; }
              asm volatile("s_waitcnt lgkmcnt(0)" ::: "memory");
#pragma unroll
              for (int dt = 0; dt < 8; ++dt) { v4u w; w.x = lo[dt].x; w.y = lo[dt].y; w.z = hi[dt].x; w.w = hi[dt].y;
                  O[dt] = __builtin_amdgcn_mfma_f32_16x16x32_bf16(__builtin_bit_cast(bf16x8, w), Pf[s], O[dt], 0, 0, 0); }
          } }
        { const float inv = 1.0f / sum; const size_t rowq = (size_t)(b * SEQ + (((nb * 128 + 16 * wave + q15) << sh) + res));
          bf16* orow = og + ((size_t)g * M + rowq) * 1024 + h * 128 + 4 * g4;
#pragma unroll
          for (int dt = 0; dt < 8; ++dt) { v2u w; w.x = pk2_hw(O[dt][0] * inv, O[dt][1] * inv); w.y = pk2_hw(O[dt][2] * inv, O[dt][3] * inv); *(v2u*)(orow + 16 * dt) = w; }
          if (g4 == 0) lse[((size_t)g * M + rowq) * 8 + h] = (mx + __builtin_amdgcn_logf(sum)) * 0.6931471805599453f; }
        AT_SYNC();
        if (has_next) AT_ISSUE_V(un);
    }
#undef AT_DECODE
#undef AT_ISSUE
#undef AT_ISSUE_K
#undef AT_ISSUE_V
#undef AT_LDQ
#undef AT_SYNC
}
__device__ __forceinline__ void ph_attn_merge(const Params& p_) {
    unsigned char* ws = opq_ptr(p_.ws);
    const int tid = opq_tid(); const int gt = opq_s(blockIdx.x) * 512 + tid, ngt = opq_s(gridDim.x) * 512;
    const bf16* og = (const bf16*)(ws + WS_OG); const float* lse = (const float*)(ws + WS_LSE); bf16* mix = (bf16*)(ws + WS_MIX);
    for (int it = gt; it < M * 128; it += ngt) {
        const int row = it >> 7, c8 = it & 127, h = c8 >> 4;
        float l0 = lse[((size_t)0 * M + row) * 8 + h], l1 = lse[((size_t)1 * M + row) * 8 + h], l2 = lse[((size_t)2 * M + row) * 8 + h];
        const float mx = fmaxf(l0, fmaxf(l1, l2)); l0 = __expf(l0 - mx); l1 = __expf(l1 - mx); l2 = __expf(l2 - mx);
        const float inv = 1.0f / (l0 + l1 + l2); l0 *= inv; l1 *= inv; l2 *= inv;
        const v4u a = *(const v4u*)(og + ((size_t)0 * M + row) * 1024 + c8 * 8), bq = *(const v4u*)(og + ((size_t)1 * M + row) * 1024 + c8 * 8), cq = *(const v4u*)(og + ((size_t)2 * M + row) * 1024 + c8 * 8);
        v4u w;
#define MRG(f) f = pk2_hw(l0 * bf2f(a.f & 0xffffu) + l1 * bf2f(bq.f & 0xffffu) + l2 * bf2f(cq.f & 0xffffu), l0 * bf2f(a.f >> 16) + l1 * bf2f(bq.f >> 16) + l2 * bf2f(cq.f >> 16))
        w.MRG(x); w.MRG(y); w.MRG(z); w.MRG(w);
#undef MRG
        *(v4u*)(mix + (size_t)row * D + c8 * 8) = w;
    }
}


constexpr int HG_QP = 0, HG_KP = 17408, HG_KPT = 34816, HG_VT = 53248, HG_TT = 71680, HG_VEC = 106496;
constexpr size_t WS_HGL = WS_HG;
constexpr size_t WS_HGD = WS_HG + (size_t)256 * 128 * 128 * 4;
template <bool OUT>
__device__ __forceinline__ void ph_hgrn(const Params& p_, int l, LAS unsigned char* lds) {
    unsigned char* ws = opq_ptr(p_.ws);
    const int tid = opq_tid(), lane = tid & 63, wave = __builtin_amdgcn_readfirstlane(tid >> 6), q15 = lane & 15, g4 = lane >> 4;
    const int kf = tid & 127, part = tid >> 7;
    const bf16* proj = (const bf16*)(ws + WS_PROJ); const float* lbp = (const float*)(ws + WS_LB) + l * 1024;
    float* Lg = (float*)(ws + WS_HGL); float* Dg = (float*)(ws + WS_HGD); bf16* mix = (bf16*)(ws + WS_MIX);
    LAS float* ptot = (LAS float*)(lds + HG_VEC); LAS float* d1s = ptot + 512; LAS float* d2s = d1s + 128; LAS float* ssb = d2s + 128;
    const int nb_ = opq_s(gridDim.x);
    for (int unit = opq_s(blockIdx.x); unit < 256; unit += nb_) {
        const int bh = unit >> 4, sc = unit & 15, b = bh >> 3, h = bh & 7;
        const float lbv = lbp[h * 128 + kf];
        f32x4 S[8];
#pragma unroll
        for (int vt = 0; vt < 8; ++vt) S[vt] = (f32x4){0.f, 0.f, 0.f, 0.f};
        if (OUT) {
            for (int i = 0; i < sc; ++i) { const int ui = bh * 16 + i; const float* Lp = Lg + (size_t)ui * 16384 + (16 * wave + 4 * g4) * 128 + q15; const float* Dp = Dg + ui * 128 + 16 * wave + 4 * g4;
                float dv[4];
#pragma unroll
                for (int r = 0; r < 4; ++r) dv[r] = Dp[r];
#pragma unroll
                for (int vt = 0; vt < 8; ++vt)
#pragma unroll
                    for (int r = 0; r < 4; ++r) S[vt][r] = dv[r] * S[vt][r] + Lp[r * 128 + 16 * vt]; }
        }
        float lsum = 0.f;
        for (int c = 0; c < 8; ++c) {
            const int row0 = b * SEQ + sc * 512 + c * 64;
            float lfc[16], omf[16]; unsigned ivb[16]; float qv[16];
            { const bf16* pr = proj + (size_t)(row0 + 16 * part) * INC + h * 128 + kf; float cs = 0.f;
#pragma unroll
              for (int i = 0; i < 16; ++i) { const float fz = bf2f(pr[(size_t)i * INC + 3072]); ivb[i] = pr[(size_t)i * INC + 4096]; if (OUT) qv[i] = silu_f(bf2f(pr[(size_t)i * INC + 5120])); else qv[i] = 0.f;
                  const float f = lbv + (1.0f - lbv) / (1.0f + __expf(-fz)); omf[i] = 1.0f - f; cs += __logf(f); lfc[i] = cs; }
              ptot[part * 128 + kf] = cs; }
            LDS_WAIT(); __syncthreads();
            { const float p0 = ptot[kf], p1 = ptot[128 + kf], p2 = ptot[256 + kf], p3 = ptot[384 + kf];
              const float b31 = p0 + p1, b63 = b31 + p2 + p3; const float pre = (part == 0) ? 0.f : (part == 1) ? p0 : (part == 2) ? b31 : b31 + p2;
              if (part == 0) { d1s[kf] = __expf(b31); d2s[kf] = __expf(b63 - b31); lsum += b63; }
              const int sg = part >> 1, hi = part & 1;
              unsigned kp[16];
#pragma unroll
              for (int i = 0; i < 16; ++i) { const float bt = pre + lfc[i]; const float kpv = omf[i] * __expf(fminf(b31 - bt, 80.f)); kp[i] = f2bf(kpv);
                  *(LAS bf16*)(lds + HG_KP + (16 * part + i) * 272 + kf * 2) = (bf16)kp[i];
                  if (OUT) *(LAS bf16*)(lds + HG_QP + (16 * part + i) * 272 + kf * 2) = (bf16)f2bf(qv[i] * __expf(fminf(bt - b31, 80.f))); }
#pragma unroll
              for (int g = 0; g < 4; ++g) { v2u wk, wv; wk.x = kp[4 * g] | (kp[4 * g + 1] << 16); wk.y = kp[4 * g + 2] | (kp[4 * g + 3] << 16); wv.x = ivb[4 * g] | (ivb[4 * g + 1] << 16); wv.y = ivb[4 * g + 2] | (ivb[4 * g + 3] << 16);
                  *(LAS v2u*)(lds + HG_KPT + kf * 144 + (32 * sg + 8 * g + 4 * hi) * 2) = wk; *(LAS v2u*)(lds + HG_VT + kf * 144 + (32 * sg + 8 * g + 4 * hi) * 2) = wv; } }
            LDS_WAIT(); __syncthreads();
            float d2v[4];
            { const LAS float* dp = d1s + 16 * wave + 4 * g4; const float a0 = dp[0], a1 = dp[1], a2 = dp[2], a3 = dp[3]; const LAS float* ep = d2s + 16 * wave + 4 * g4; d2v[0] = ep[0]; d2v[1] = ep[1]; d2v[2] = ep[2]; d2v[3] = ep[3];
#pragma unroll
              for (int vt = 0; vt < 8; ++vt) { S[vt][0] *= a0; S[vt][1] *= a1; S[vt][2] *= a2; S[vt][3] *= a3;
                  if (OUT) { v2u w; w.x = pk2_hw(S[vt][0], S[vt][1]); w.y = pk2_hw(S[vt][2], S[vt][3]); *(LAS v2u*)(lds + HG_TT + (16 * vt + q15) * 272 + (16 * wave + 4 * g4) * 2) = w; } } }
            const int tt = wave & 3, vh = wave >> 2;
            bf16x8 Qf[4], ATp[2];
            if (OUT) {
#pragma unroll
                for (int ks = 0; ks < 4; ++ks) Qf[ks] = *(const LAS bf16x8*)(lds + HG_QP + (16 * tt + q15) * 272 + (32 * ks + 8 * g4) * 2);
                f32x4 AT[4];
#pragma unroll
                for (int st = 0; st < 4; ++st) { AT[st] = (f32x4){0.f, 0.f, 0.f, 0.f};
                    if (st <= tt) {
#pragma unroll
                        for (int ks = 0; ks < 4; ++ks) { const bf16x8 a = *(const LAS bf16x8*)(lds + HG_KP + (16 * st + q15) * 272 + (32 * ks + 8 * g4) * 2); AT[st] = __builtin_amdgcn_mfma_f32_16x16x32_bf16(a, Qf[ks], AT[st], 0, 0, 0); }
                        if (st == tt) {
#pragma unroll
                            for (int r = 0; r < 4; ++r) if (4 * g4 + r > q15) AT[st][r] = 0.f; } } }
#pragma unroll
                for (int sg = 0; sg < 2; ++sg) { v4u w; w.x = pk2_hw(AT[2 * sg][0], AT[2 * sg][1]); w.y = pk2_hw(AT[2 * sg][2], AT[2 * sg][3]); w.z = pk2_hw(AT[2 * sg + 1][0], AT[2 * sg + 1][1]); w.w = pk2_hw(AT[2 * sg + 1][2], AT[2 * sg + 1][3]); ATp[sg] = __builtin_bit_cast(bf16x8, w); }
            }
            LDS_WAIT(); __syncthreads();
            f32x4 O[4];
            if (OUT) {
                float ssq = 0.f;
#pragma unroll
                for (int j = 0; j < 4; ++j) { const int vt = 4 * vh + j; O[j] = (f32x4){0.f, 0.f, 0.f, 0.f};
#pragma unroll
                    for (int sg = 0; sg < 2; ++sg) if (2 * sg <= tt) { const bf16x8 a = *(const LAS bf16x8*)(lds + HG_VT + (16 * vt + q15) * 144 + (32 * sg + 8 * g4) * 2); O[j] = __builtin_amdgcn_mfma_f32_16x16x32_bf16(a, ATp[sg], O[j], 0, 0, 0); }
#pragma unroll
                    for (int ks = 0; ks < 4; ++ks) { const bf16x8 a = *(const LAS bf16x8*)(lds + HG_TT + (16 * vt + q15) * 272 + (32 * ks + 8 * g4) * 2); O[j] = __builtin_amdgcn_mfma_f32_16x16x32_bf16(a, Qf[ks], O[j], 0, 0, 0); }
                    ssq += (O[j][0] * O[j][0] + O[j][1] * O[j][1]) + (O[j][2] * O[j][2] + O[j][3] * O[j][3]); }
                ssq += __shfl_xor(ssq, 16); ssq += __shfl_xor(ssq, 32);
                if (g4 == 0) ssb[vh * 64 + 16 * tt + q15] = ssq;
            }
            { bf16x8 Ka[2];
#pragma unroll
              for (int sg = 0; sg < 2; ++sg) Ka[sg] = *(const LAS bf16x8*)(lds + HG_KPT + (16 * wave + q15) * 144 + (32 * sg + 8 * g4) * 2);
#pragma unroll
              for (int vt = 0; vt < 8; ++vt) {
#pragma unroll
                  for (int sg = 0; sg < 2; ++sg) { const bf16x8 bv = *(const LAS bf16x8*)(lds + HG_VT + (16 * vt + q15) * 144 + (32 * sg + 8 * g4) * 2); S[vt] = __builtin_amdgcn_mfma_f32_16x16x32_bf16(Ka[sg], bv, S[vt], 0, 0, 0); }
                  S[vt][0] *= d2v[0]; S[vt][1] *= d2v[1]; S[vt][2] *= d2v[2]; S[vt][3] *= d2v[3]; } }
            LDS_WAIT(); __syncthreads();
            if (OUT) {
                const int t = 16 * tt + q15; const float rr = 1.0f / sqrtf((ssb[t] + ssb[64 + t]) * (1.0f / 128.0f) + RMS_EPS);
                const size_t row = (size_t)(row0 + t);
#pragma unroll
                for (int j = 0; j < 4; ++j) { const int v0 = 16 * (4 * vh + j) + 4 * g4;
                    const v2u gz = *(const v2u*)(proj + row * INC + 6144 + h * 128 + v0); const f32x4 gn = *(const f32x4*)(p_.hg_norm + l * 1024 + h * 128 + v0);
                    v2u w; w.x = pk2_hw(O[j][0] * rr * gn[0] * silu_f(bf2f(gz.x & 0xffffu)), O[j][1] * rr * gn[1] * silu_f(bf2f(gz.x >> 16)));
                    w.y = pk2_hw(O[j][2] * rr * gn[2] * silu_f(bf2f(gz.y & 0xffffu)), O[j][3] * rr * gn[3] * silu_f(bf2f(gz.y >> 16)));
                    *(v2u*)(mix + row * D + 1024 + h * 128 + v0) = w; }
            }
        }
        if (!OUT) {
            float* Lp = Lg + (size_t)unit * 16384 + (16 * wave + 4 * g4) * 128 + q15;
#pragma unroll
            for (int vt = 0; vt < 8; ++vt)
#pragma unroll
                for (int r = 0; r < 4; ++r) Lp[r * 128 + 16 * vt] = S[vt][r];
            if (part == 0) Dg[unit * 128 + kf] = __expf(lsum);
        }
        __syncthreads();
    }
}

constexpr int PH_PER_LAYER = 12, PH_BASE = 2, N_PHASES = PH_BASE + DEPTH * PH_PER_LAYER;
__global__ void __launch_bounds__(512, 2) k_fwd(Params p) {
    extern __shared__ __attribute__((aligned(16))) unsigned char lds_raw[];
    LAS unsigned char* lds = (LAS unsigned char*)lds_raw;
    const int tid = threadIdx.x;
    for (int u = tid; u < (LDS_BYTES - RING_BYTES) / 4; u += 512) ((LAS unsigned*)(lds + RING_BYTES))[u] = 0u;
    __syncthreads();
    XcdBarrier bar; { unsigned char* ws = p.ws; bar.bar = (unsigned*)(ws + WS_CTL) + CW_BAR; bar.x = 0; bar.st = nullptr;
    if (p.ph_hi - p.ph_lo > 1) bar = xcd_barrier_post((unsigned*)(ws + WS_CTL) + CW_BAR, (volatile LAS unsigned*)(lds + MISC_OFF) + 8); }
#define RUN(k) (p.ph_lo <= (k) && (k) < p.ph_hi)
#define SEAM(k) do { if (RUN(k) && RUN((k) + 1)) xcd_barrier(bar); } while (0)
#define SITE() unsigned char* ws = opq_ptr(p.ws); const int G = opq_s(gridDim.x), c = opq_s(blockIdx.x); const float* rstdx = (const float*)(ws + WS_RSTDX); \
    bf16* xb = (bf16*)(ws + WS_XB); bf16* proj = (bf16*)(ws + WS_PROJ); bf16* mix = (bf16*)(ws + WS_MIX); float* Y = (float*)(ws + WS_Y); float* part = (float*)(ws + WS_PART); \
    (void)rstdx; (void)xb; (void)proj; (void)mix; (void)Y; (void)part; (void)G; (void)c;
    if (RUN(0)) ph_prologue(p, lds);
    SEAM(0);
    if (RUN(1)) { SITE()
        pg8::Gemm g{(const bf16*)(ws + WS_MEMB), (const bf16*)(ws + WS_WCKV), MROWS, DEPTH * NCKV, D}; pg8::StaticOrder S; S.init(MROWS, DEPTH * NCKV, G, c);
        pg8::EpiCkv E{(bf16*)(ws + WS_CKV), (bf16*)(ws + WS_CVT), (const float*)(ws + WS_RSTDM)};
        pg8::gemm_phase<pg8::EpiCkv, pg8::StaticOrder, PG8_ALIGN, PG8_SP2>(lds, g, S, E);
    }
    SEAM(1);
    for (int l = 0; l < DEPTH; ++l) {
        const int pb = PH_BASE + l * PH_PER_LAYER;
        const float* gl = p.gains + (size_t)l * 7 * D;
        if (RUN(pb + 0)) { SITE()
            pg8::Gemm g{xb, (const bf16*)(ws + WS_WIN) + (size_t)l * INC * D, M, INC, D}; pg8::StaticOrder S; S.init(M, INC, G, c);
            pg8::EpiScaleBf16 E{proj, INC, rstdx};
            pg8::gemm_phase<pg8::EpiScaleBf16, pg8::StaticOrder, PG8_ALIGN, PG8_SP2>(lds, g, S, E);
        }
        SEAM(pb + 0);
        if (RUN(pb + 1)) { ph_hgrn<false>(p, l, lds); ph_attn(p, lds); }
        SEAM(pb + 1);
        if (RUN(pb + 2)) { ph_hgrn<true>(p, l, lds); ph_attn_merge(p); }
        SEAM(pb + 2);
        if (RUN(pb + 3)) { SITE()
            pg8::Gemm g{mix, (const bf16*)(ws + WS_WOUT) + (size_t)l * D * D, M, D, D}; pg8::StaticOrder S; S.init(M, D, G, c);
            pg8::EpiF32Stats E{Y, D, part};
            pg8::gemm_phase<pg8::EpiF32Stats, pg8::StaticOrder, PG8_ALIGN, PG8_SP2>(lds, g, S, E);
        }
        SEAM(pb + 3);
        if (RUN(pb + 4)) ph_resnorm(p, gl + 1 * D);
        SEAM(pb + 4);
        if (RUN(pb + 5)) { SITE()
            pg8::Gemm g{xb, (const bf16*)(ws + WS_WCQ) + (size_t)l * D * D, M, D, D}; pg8::StaticOrder S; S.init(M, D, G, c);
            pg8::EpiScaleBf16 E{proj, D, rstdx};
            pg8::gemm_phase<pg8::EpiScaleBf16, pg8::StaticOrder, PG8_ALIGN, PG8_SP2>(lds, g, S, E);
        }
        SEAM(pb + 5);
        if (RUN(pb + 6)) ph_cross(p, l, lds);
        SEAM(pb + 6);
        if (RUN(pb + 7)) { SITE()
            pg8::Gemm g{mix, (const bf16*)(ws + WS_WCO) + (size_t)l * D * D, M, D, D}; pg8::StaticOrder S; S.init(M, D, G, c);
            pg8::EpiF32Stats E{Y, D, part};
            pg8::gemm_phase<pg8::EpiF32Stats, pg8::StaticOrder, PG8_ALIGN, PG8_SP2>(lds, g, S, E);
        }
        SEAM(pb + 7);
        if (RUN(pb + 8)) ph_resnorm(p, gl + 4 * D);
        SEAM(pb + 8);
        if (RUN(pb + 9)) { SITE()
            pg8::Gemm g{xb, (const bf16*)(ws + WS_WGU) + (size_t)l * NGU * D, M, NGU, D}; pg8::StaticOrder S; S.init(M, NGU, G, c);
            pg8::EpiSwiGLU E{proj, DFF, rstdx};
            pg8::gemm_phase<pg8::EpiSwiGLU, pg8::StaticOrder, PG8_ALIGN, PG8_SP2>(lds, g, S, E);
        }
        SEAM(pb + 9);
        if (RUN(pb + 10)) { SITE()
            pg8::Gemm g{proj, (const bf16*)(ws + WS_WDN) + (size_t)l * D * DFF, M, D, DFF}; pg8::StaticOrder S; S.init(M, D, G, c);
            pg8::EpiF32Stats E{Y, D, part};
            pg8::gemm_phase<pg8::EpiF32Stats, pg8::StaticOrder, PG8_ALIGN, PG8_SP2>(lds, g, S, E);
        }
        SEAM(pb + 10);
        if (RUN(pb + 11)) ph_resnorm(p, gl + 6 * D);
        SEAM(pb + 11);
    }
#undef RUN
#undef SEAM
#undef SITE
}

#ifndef MK_ONE_LAUNCH
#define MK_ONE_LAUNCH 1
#endif
extern "C" void kernel_launch(void* const* d_in, const int* in_sizes, int n_in, void* d_out, int out_size, void* d_ws, size_t ws_size, hipStream_t stream) {
    static int grid = 0;
    if (grid == 0) {
        if (n_in != 13 || in_sizes[0] != M * D || out_size != M * D || ws_size < WS_END) { fprintf(stderr, "kernel_launch: unexpected shapes/workspace: n_in %d in0 %d out %d ws %zu (need %zu); nothing launched\n", n_in, n_in > 0 ? in_sizes[0] : -1, out_size, ws_size, (size_t)WS_END); grid = -1; return; }
        int dev = 0, cus = 0, per_cu = 0;
        if (hipGetDevice(&dev) != hipSuccess || hipDeviceGetAttribute(&cus, hipDeviceAttributeMultiprocessorCount, dev) != hipSuccess) { grid = -1; return; }
        if (hipFuncSetAttribute((const void*)k_fwd, hipFuncAttributeMaxDynamicSharedMemorySize, LDS_BYTES) != hipSuccess) { fprintf(stderr, "kernel_launch: hipFuncSetAttribute failed\n"); grid = -1; return; }
        if (hipOccupancyMaxActiveBlocksPerMultiprocessor(&per_cu, (const void*)k_fwd, 512, LDS_BYTES) != hipSuccess || per_cu < 1) fprintf(stderr, "kernel_launch: note: occupancy query says %d\n", per_cu);
        (void)hipGetLastError();
        grid = cus;
    }
    if (grid < 0) return;
    (void)hipMemsetAsync((char*)d_ws + WS_CTL, 0, CTL_ZERO_BYTES, stream);
    Params p{};
    p.x = (const float*)d_in[0]; p.mem = (const float*)d_in[1]; p.rel_bias = (const float*)d_in[2]; p.lb_logits = (const float*)d_in[3]; p.gains = (const float*)d_in[4];
    p.w_in = (const float*)d_in[5]; p.hg_norm = (const float*)d_in[6]; p.w_out = (const float*)d_in[7]; p.w_cq = (const float*)d_in[8]; p.w_ckv = (const float*)d_in[9];
    p.w_co = (const float*)d_in[10]; p.w_gu = (const float*)d_in[11]; p.w_dn = (const float*)d_in[12];
    p.out = (float*)d_out; p.ws = (unsigned char*)d_ws;
#if MK_ONE_LAUNCH
    p.ph_lo = 0; p.ph_hi = N_PHASES;
    hipLaunchKernelGGL(k_fwd, dim3(grid), dim3(512), LDS_BYTES, stream, p);
#else
    for (int ph = 0; ph < N_PHASES; ++ph) { p.ph_lo = ph; p.ph_hi = ph + 1; hipLaunchKernelGGL(k_fwd, dim3(grid), dim3(512), LDS_BYTES, stream, p); }
#endif
}
```
